# Optimizing an MI355X kernel written in HIP

```python
import math
import jax, jax.numpy as jnp
from jax import lax
import numpy as np

D_MODEL = 2048
BATCH = 1
SEQ = 8192
DEPTH = 1

CHUNK = 64
Q_BLOCK = 128
HEAD_DIM = 128
N_HEADS_DIFF = D_MODEL // 256
DIFF_QK_DIM = HEAD_DIM // 2
N_HEADS_FOX = D_MODEL // 256
WIDTH_DIFF = N_HEADS_DIFF * HEAD_DIM
WIDTH_FOX = N_HEADS_FOX * HEAD_DIM
D_IN_PROJ = 3 * WIDTH_DIFF + 3 * WIDTH_FOX + N_HEADS_FOX
D_FF = 4 * D_MODEL
EPS = 1e-6

OFF_QA = WIDTH_DIFF
OFF_KA = 2 * WIDTH_DIFF
OFF_VA = 3 * WIDTH_DIFF
OFF_QB = 3 * WIDTH_DIFF + WIDTH_FOX
OFF_KB = 3 * WIDTH_DIFF + 2 * WIDTH_FOX
OFF_VB = 3 * WIDTH_DIFF + 3 * WIDTH_FOX

kernel_name = "hybrid_diff_fox_gated_block"


def rms_norm(x, g):
    xf = x.astype(jnp.float32)
    r = lax.rsqrt(jnp.mean(xf * xf, axis=-1, keepdims=True) + EPS)
    return (xf * r).astype(x.dtype) * g


def alibi_slopes(n_heads):
    return 2.0 ** (-8.0 * jnp.arange(1, n_heads + 1, dtype=jnp.float32) / n_heads)


def diff_attention(q1, q2, k1, k2, v, lam, slopes):
    S = q1.shape[2]
    scale = DIFF_QK_DIM ** -0.5
    outs = []
    for start in range(0, S, Q_BLOCK):
        end = start + Q_BLOCK
        t = jnp.arange(start, end)[:, None]
        s = jnp.arange(end)[None, :]
        allowed = (s // CHUNK) <= (t // CHUNK)
        bias = -slopes[:, None, None] * jnp.abs(t - s).astype(jnp.float32)
        bias = jnp.where(allowed[None], bias, -jnp.inf)

        def probs(q, k):
            logits = jnp.einsum('bhqd,bhkd->bhqk', q[:, :, start:end], k[:, :, :end]).astype(jnp.float32)
            return jax.nn.softmax(logits * scale + bias[None], axis=-1)

        p = probs(q1, k1) - lam * probs(q2, k2)
        outs.append(jnp.einsum('bhqk,bhkd->bhqd', p.astype(v.dtype), v[:, :, :end]))
    return jnp.concatenate(outs, axis=2)


def forgetting_attention(q, k, v, log_f_cum):
    S = q.shape[2]
    scale = HEAD_DIM ** -0.5
    outs = []
    for start in range(0, S, Q_BLOCK):
        end = start + Q_BLOCK
        t = jnp.arange(start, end)[:, None]
        s = jnp.arange(end)[None, :]
        allowed = s <= t
        decay = log_f_cum[:, :, start:end, None] - log_f_cum[:, :, None, :end]
        logits = jnp.einsum('bhqd,bhkd->bhqk', q[:, :, start:end], k[:, :, :end]).astype(jnp.float32)
        logits = jnp.where(allowed[None, None], logits * scale + decay, -jnp.inf)
        p = jax.nn.softmax(logits, axis=-1)
        outs.append(jnp.einsum('bhqk,bhkd->bhqd', p.astype(v.dtype), v[:, :, :end]))
    return jnp.concatenate(outs, axis=2)


def setup_inputs(seed: int = 0) -> dict:
    key = jax.random.key(seed)
    ks = jax.random.split(key, 24)
    f32 = jnp.float32

    def dense(k, fan_in, fan_out):
        return jax.random.normal(k, (DEPTH, fan_in, fan_out), f32) * fan_in ** -0.5

    def gain(k, n):
        return 1.0 + 0.05 * jax.random.normal(k, (DEPTH, n), f32)

    def small(k, n, scale=0.01):
        return scale * jax.random.normal(k, (DEPTH, n), f32)

    return {
        "x": jax.random.normal(ks[0], (BATCH, SEQ, D_MODEL), f32),
        "norm_mix": gain(ks[1], D_MODEL),
        "w_in": dense(ks[2], D_MODEL, D_IN_PROJ),
        "b_forget": 2.0 + 0.5 * jax.random.normal(ks[3], (DEPTH, N_HEADS_FOX), f32),
        "qnorm_diff": gain(ks[4], DIFF_QK_DIM),
        "knorm_diff": gain(ks[5], DIFF_QK_DIM),
        "lambda_q1": small(ks[6], DIFF_QK_DIM, 0.1),
        "lambda_k1": small(ks[7], DIFF_QK_DIM, 0.1),
        "lambda_q2": small(ks[8], DIFF_QK_DIM, 0.1),
        "lambda_k2": small(ks[9], DIFF_QK_DIM, 0.1),
        "subln_diff": gain(ks[10], HEAD_DIM),
        "qnorm_fox": gain(ks[11], HEAD_DIM),
        "knorm_fox": gain(ks[12], HEAD_DIM),
        "w_branch_diff": dense(ks[13], WIDTH_DIFF, D_MODEL),
        "w_branch_fox": dense(ks[14], WIDTH_FOX, D_MODEL),
        "w_gate": dense(ks[15], D_MODEL, 2 * D_MODEL),
        "b_gate": small(ks[16], 2 * D_MODEL),
        "w_out": dense(ks[17], D_MODEL, D_MODEL),
        "norm_mlp": gain(ks[18], D_MODEL),
        "w_mlp_up": dense(ks[19], D_MODEL, D_FF),
        "w_mlp_down": dense(ks[20], D_FF, D_MODEL),
    }


def reference(x, norm_mix, w_in, b_forget, qnorm_diff, knorm_diff, lambda_q1, lambda_k1,
              lambda_q2, lambda_k2, subln_diff, qnorm_fox, knorm_fox, w_branch_diff, w_branch_fox,
              w_gate, b_gate, w_out, norm_mlp, w_mlp_up, w_mlp_down):
    B, S, D = x.shape
    slopes = alibi_slopes(N_HEADS_DIFF)
    for layer in range(DEPTH):
        lambda_init = 0.8 - 0.6 * math.exp(-0.3 * layer)

        h = rms_norm(x, norm_mix[layer])
        proj = h @ w_in[layer]
        qa = proj[..., :OFF_QA]
        ka = proj[..., OFF_QA:OFF_KA]
        va = proj[..., OFF_KA:OFF_VA]
        qb = proj[..., OFF_VA:OFF_QB]
        kb = proj[..., OFF_QB:OFF_KB]
        vb = proj[..., OFF_KB:OFF_VB]
        f_logit = proj[..., OFF_VB:]

        qa = rms_norm(qa.reshape(B, S, N_HEADS_DIFF, 2, DIFF_QK_DIM), qnorm_diff[layer])
        ka = rms_norm(ka.reshape(B, S, N_HEADS_DIFF, 2, DIFF_QK_DIM), knorm_diff[layer])
        qa = jnp.transpose(qa, (0, 2, 3, 1, 4))
        ka = jnp.transpose(ka, (0, 2, 3, 1, 4))
        va = jnp.transpose(va.reshape(B, S, N_HEADS_DIFF, HEAD_DIM), (0, 2, 1, 3))
        lam = (jnp.exp(jnp.sum(lambda_q1[layer] * lambda_k1[layer]).astype(jnp.float32))
               - jnp.exp(jnp.sum(lambda_q2[layer] * lambda_k2[layer]).astype(jnp.float32))
               + lambda_init)
        oa = diff_attention(qa[:, :, 0], qa[:, :, 1], ka[:, :, 0], ka[:, :, 1], va, lam, slopes)
        oa = rms_norm(oa, subln_diff[layer]) * (1.0 - lambda_init)
        oa = jnp.transpose(oa, (0, 2, 1, 3)).reshape(B, S, WIDTH_DIFF)

        qb = rms_norm(qb.reshape(B, S, N_HEADS_FOX, HEAD_DIM), qnorm_fox[layer])
        kb = rms_norm(kb.reshape(B, S, N_HEADS_FOX, HEAD_DIM), knorm_fox[layer])
        qb = jnp.transpose(qb, (0, 2, 1, 3))
        kb = jnp.transpose(kb, (0, 2, 1, 3))
        vb = jnp.transpose(vb.reshape(B, S, N_HEADS_FOX, HEAD_DIM), (0, 2, 1, 3))
        log_f = jax.nn.log_sigmoid(f_logit.astype(jnp.float32) + b_forget[layer].astype(jnp.float32))
        log_f_cum = jnp.transpose(jnp.cumsum(log_f, axis=1), (0, 2, 1))
        ob = forgetting_attention(qb, kb, vb, log_f_cum)
        ob = jnp.transpose(ob, (0, 2, 1, 3)).reshape(B, S, WIDTH_FOX)

        gates = jax.nn.sigmoid((h @ w_gate[layer] + b_gate[layer]).astype(jnp.float32)).astype(h.dtype)
        g_diff = gates[..., :D_MODEL]
        g_fox = gates[..., D_MODEL:]
        merged = g_diff * (oa @ w_branch_diff[layer]) + g_fox * (ob @ w_branch_fox[layer])
        x = x + merged @ w_out[layer]

        h2 = rms_norm(x, norm_mlp[layer])
        u = jax.nn.relu(h2 @ w_mlp_up[layer])
        x = x + (u * u) @ w_mlp_down[layer]
    return x
```

```cpp
#include <hip/hip_runtime.h>
#include <hip/hip_cooperative_groups.h>
#include <cstdio>
#include <cstdint>
namespace cg = cooperative_groups;

#ifndef REPEAT_PHASE
#define REPEAT_PHASE -1
#endif
#ifndef MK_N_LAUNCHES
#define MK_N_LAUNCHES 1
#endif

#define LAS __attribute__((address_space(3)))
typedef unsigned short bf16_t;
typedef short bf16x8 __attribute__((ext_vector_type(8)));
typedef float f32x4 __attribute__((ext_vector_type(4)));
typedef float f32x16 __attribute__((ext_vector_type(16)));
typedef unsigned u32x4 __attribute__((ext_vector_type(4)));
typedef unsigned u32x2 __attribute__((ext_vector_type(2)));

constexpr int SEQ = 8192, DM = 2048, NPROJ = 6152, FF = 8192;
constexpr float EPS = 1e-6f, LOG2E = 1.4426950408889634f;
constexpr int NTHREADS = 512, NWAVES = 8;

constexpr size_t MiB = 1u << 20;
constexpr size_t WS_LF = 0;
constexpr size_t WS_C2 = 256 * 1024;
constexpr size_t WS_GN = 512 * 1024;
constexpr size_t WS_CTL = 768 * 1024;
constexpr size_t CTL_BYTES = 32768;
constexpr size_t WS_SS2 = 1 * MiB;
constexpr size_t WS_WBD = 8 * MiB, WS_WBF = 12 * MiB, WS_WOUT = 16 * MiB;
constexpr size_t WS_WT1 = 24 * MiB, WS_WUP = 24 * MiB;
constexpr size_t WS_WT2 = 56 * MiB;
constexpr size_t WS_H = 64 * MiB, WS_WDOWN = 64 * MiB;
constexpr size_t WS_QA = 96 * MiB, WS_KA = 112 * MiB, WS_QB = 128 * MiB, WS_KB = 144 * MiB;
constexpr size_t WS_MGT = 96 * MiB;
constexpr size_t WS_VT = 160 * MiB, WS_MG = 160 * MiB;
constexpr size_t WS_G = 192 * MiB;
constexpr size_t WS_OA = 256 * MiB, WS_OB = 272 * MiB, WS_XG = 256 * MiB;
constexpr size_t WS_X1B = 224 * MiB;
constexpr size_t WS_U = 96 * MiB;
constexpr size_t WS_END = 288 * MiB;

constexpr int GEMM_LDS = 131072;
constexpr int EPI_SCR_OFF = GEMM_LDS;
constexpr int LDS_BYTES = GEMM_LDS + 4096 + 1024;
constexpr int LDS_BAR_OFF = LDS_BYTES - 16;
constexpr int P0_SCR_STRIDE = 8704, P0_WF_OFF = 8 * P0_SCR_STRIDE;
static_assert(P0_WF_OFF + 65536 <= LDS_BAR_OFF, "P0 LDS map");

typedef float f32x2_t __attribute__((ext_vector_type(2)));
typedef __bf16 bf16x2_t __attribute__((ext_vector_type(2)));
__device__ __forceinline__ unsigned cvt_pk_bf16(float lo, float hi) { const f32x2_t v = {lo, hi}; const bf16x2_t b = __builtin_convertvector(v, bf16x2_t); return __builtin_bit_cast(unsigned, b); }
__device__ __forceinline__ u32x4 pack8(const f32x4& a, const f32x4& b) { u32x4 w; w.x = cvt_pk_bf16(a[0], a[1]); w.y = cvt_pk_bf16(a[2], a[3]); w.z = cvt_pk_bf16(b[0], b[1]); w.w = cvt_pk_bf16(b[2], b[3]); return w; }
__device__ __forceinline__ float bf_lo(unsigned u) { return __uint_as_float(u << 16); }
__device__ __forceinline__ float bf_hi(unsigned u) { return __uint_as_float(u & 0xffff0000u); }
__device__ __forceinline__ float fast_exp2(float x) { return __builtin_amdgcn_exp2f(x); }
__device__ __forceinline__ float fast_rcp(float x) { return __builtin_amdgcn_rcpf(x); }
__device__ __forceinline__ float fast_rsq(float x) { return __builtin_amdgcn_rsqf(x); }
__device__ __forceinline__ float wave_sum(float v) {
#pragma unroll
    for (int o = 1; o < 64; o <<= 1) v += __shfl_xor(v, o);
    return v;
}
#define LDS_WAIT() asm volatile("s_waitcnt lgkmcnt(0)" ::: "memory")

namespace pg8 {
constexpr int BM = 256, BK = 64, HALF = 128, HTB = HALF * BK * 2, STAGE_BYTES = 8 * HTB, NXCD = 8, WGM = 8;
__host__ __device__ __forceinline__ int lds_byte(int r, int c) { const int st = (r >> 4) * 2 + (c >> 5), rr = r & 15, cc = c & 31, ob = rr * 64 + cc * 2; return st * 1024 + (ob ^ (((ob >> 9) & 1) << 5)); }
__host__ __device__ __forceinline__ void stage_rc(int b, int& R, int& C) { const int st = b / 1024, sb = b % 1024, swz = sb ^ (((sb >> 9) & 1) << 5); R = (st >> 1) * 16 + swz / 64; C = (st & 1) * 32 + (swz % 64) / 2; }
__host__ __device__ __forceinline__ int perm32(int rho) { const int n = rho >> 4, i = rho & 15; return 8 * (i >> 2) + 4 * n + (i & 3); }

struct Unit { int pm, pn, sel; };
struct Gemm { const bf16_t *A0, *A1, *B0, *B1; int K; };

__host__ __device__ __forceinline__ void map_tile(int L, int nM, int nN, Unit& u) {
    const int nwg = nM * nN; int wgid = L;
    { const int q = nwg / NXCD, r = nwg % NXCD, xcd = wgid % NXCD, off = wgid / NXCD; wgid = (xcd < r ? xcd * (q + 1) : r * (q + 1) + (xcd - r) * q) + off; }
    const int nig = WGM * nN, gid = wgid / nig, fm = gid * WGM, gsz = (nM - fm) < WGM ? (nM - fm) : WGM;
    u.pm = fm + ((wgid % nig) % gsz); u.pn = (wgid % nig) / gsz;
}
struct PlainOrder { int nM, nN, G, c;
    __device__ __forceinline__ bool next(int i, Unit& u) const { const long L = (long)i * G + c; if (L >= (long)nM * nN) return false; map_tile((int)L, nM, nN, u); u.sel = 0; return true; } };
struct P1Order { int G, c;
    __device__ __forceinline__ bool next(int i, Unit& u) const { long L = (long)i * G + c; if (L < 1024) { map_tile((int)L, 32, 32, u); u.sel = 0; return true; } L -= 1024; if (L < 256) { map_tile((int)L, 8, 32, u); u.sel = 1; return true; } return false; } };
struct P3Order { int G, c;
    __device__ __forceinline__ bool next(int i, Unit& u) const { const long L = (long)(i >> 1) * G + c; if (L >= 256) return false; map_tile((int)L, 32, 8, u); u.sel = i & 1; return true; } };

template <class Epi, class Sched>
__device__ __forceinline__ void gemm_phase(LAS unsigned char* lds, const Gemm g, const Sched& S, const Epi& E) {
    const int tid = threadIdx.x, wid = __builtin_amdgcn_readfirstlane(tid >> 6), lane = tid & 63, wr = wid >> 2, wc = wid & 3, fr = lane & 15, fq = lane >> 4;
    const int K = g.K, nt = K / BK;
    unsigned voffA[2], voffB[2];
#pragma unroll
    for (int i = 0; i < 2; ++i) { int R, C; stage_rc(tid * 16 + i * 8192, R, C); const int Rb = 64 * (R >> 5) + perm32(R & 31);
        voffA[i] = (unsigned)(R * K + C) * 2u; voffB[i] = (unsigned)(Rb * K + C) * 2u; }
    const size_t kstep = (size_t)(BK * 2);
    const size_t hstep = (size_t)HALF * K * 2;
    const size_t hstepB = (size_t)32 * K * 2;
    const size_t tstep = 2 * hstep;
    const unsigned ldsw = (unsigned)wid * 1024u;
    const int aoff = lds_byte(wr * 64 + fr, fq * 8), boff = lds_byte(wc * 32 + fr, fq * 8);
#define PG8_SA(b, h) (((b) * 2 + (h)) * HTB)
#define PG8_SB(b, h) ((4 + (b) * 2 + (h)) * HTB)
#define PG8_STAGE(bufoff, gbase, voff) do { _Pragma("unroll") for (int _i = 0; _i < 2; ++_i) \
        __builtin_amdgcn_global_load_lds((const unsigned*)((const char*)(gbase) + (voff)[_i]), (LAS unsigned*)(lds + (bufoff) + ldsw + _i * 8192), 16, 0, 0); } while (0)
#define PG8_LDA(dst, b, h) do { _Pragma("unroll") for (int m = 0; m < 4; ++m) _Pragma("unroll") for (int k = 0; k < 2; ++k) dst[m][k] = *(const LAS bf16x8*)(lds + PG8_SA(b, h) + aoff + m * 2048 + k * 1024); } while (0)
#define PG8_LDB(dst, b, h) do { _Pragma("unroll") for (int n = 0; n < 2; ++n) _Pragma("unroll") for (int k = 0; k < 2; ++k) dst[n][k] = *(const LAS bf16x8*)(lds + PG8_SB(b, h) + boff + n * 2048 + k * 1024); } while (0)
#define PG8_MMA(ai, bj, At, Bt) do { __builtin_amdgcn_s_setprio(1); _Pragma("unroll") for (int m = 0; m < 4; ++m) _Pragma("unroll") for (int n = 0; n < 2; ++n) _Pragma("unroll") for (int k = 0; k < 2; ++k) \
        acc[ai][bj][m][n] = __builtin_amdgcn_mfma_f32_16x16x32_bf16(Bt[n][k], At[m][k], acc[ai][bj][m][n], 0, 0, 0); __builtin_amdgcn_s_setprio(0); } while (0)
#define PG8_WAIT_V(n) asm volatile("s_waitcnt vmcnt(" #n ")" ::: "memory")
#define PG8_WAIT_L(n) asm volatile("s_waitcnt lgkmcnt(" #n ")" ::: "memory")
#define PG8_BAR __builtin_amdgcn_s_barrier()
#define PG8_SCHED __builtin_amdgcn_sched_barrier(0)
    Unit cur, nxt; int ui = 0;
    if (!S.next(0, cur)) return;
    f32x4 acc[2][2][4][2];
#pragma unroll
    for (int a = 0; a < 2; ++a)
#pragma unroll
        for (int b = 0; b < 2; ++b)
#pragma unroll
            for (int m = 0; m < 4; ++m)
#pragma unroll
                for (int n = 0; n < 2; ++n) acc[a][b][m][n] = (f32x4){0.f, 0.f, 0.f, 0.f};
    bf16x8 At[4][2], B0[2][2], B1[2][2];
    const char* cA = (const char*)(cur.sel ? g.A1 : g.A0) + (size_t)cur.pm * tstep; const char* cB = (const char*)(cur.sel ? g.B1 : g.B0) + (size_t)cur.pn * tstep;
    PG8_STAGE(PG8_SB(0, 0), cB, voffB); PG8_STAGE(PG8_SB(0, 1), cB + hstepB, voffB); PG8_STAGE(PG8_SA(0, 0), cA, voffA); PG8_STAGE(PG8_SA(0, 1), cA + hstep, voffA);
    if (wr == 1) PG8_BAR;
    PG8_WAIT_V(2); PG8_BAR;
    PG8_STAGE(PG8_SB(1, 0), cB + kstep, voffB); PG8_STAGE(PG8_SA(1, 0), cA + kstep, voffA); PG8_STAGE(PG8_SB(1, 1), cB + hstepB + kstep, voffB);
    PG8_WAIT_V(6); PG8_BAR;
    for (;;) {
        const bool has_next = S.next(ui + 1, nxt);
        const char* nA = has_next ? (const char*)(nxt.sel ? g.A1 : g.A0) + (size_t)nxt.pm * tstep : cA; const char* nB = has_next ? (const char*)(nxt.sel ? g.B1 : g.B0) + (size_t)nxt.pn * tstep : cB;
        for (int t = 0; t < nt; t += 2) {
            const bool last = (t == nt - 2);
            const char* a1 = cA + (size_t)(t + 1) * kstep;
            const char* a2 = last ? nA : cA + (size_t)(t + 2) * kstep; const char* b2 = last ? nB : cB + (size_t)(t + 2) * kstep;
            const char* a3 = a2 + kstep; const char* b3 = b2 + kstep;
            PG8_LDB(B0, 0, 0); PG8_LDB(B1, 0, 1); PG8_SCHED; PG8_LDA(At, 0, 0); PG8_STAGE(PG8_SA(1, 1), a1 + hstep, voffA);
            PG8_WAIT_V(8); PG8_WAIT_L(0); PG8_BAR; PG8_MMA(0, 0, At, B0); PG8_MMA(0, 1, At, B1); PG8_BAR; PG8_SCHED;
            PG8_LDA(At, 0, 1); PG8_STAGE(PG8_SB(0, 0), b2, voffB); PG8_STAGE(PG8_SB(0, 1), b2 + hstepB, voffB); PG8_STAGE(PG8_SA(0, 0), a2, voffA);
            PG8_WAIT_V(8); PG8_WAIT_L(0); PG8_BAR; PG8_MMA(1, 0, At, B0); PG8_MMA(1, 1, At, B1); PG8_BAR; PG8_SCHED;
            PG8_LDB(B0, 1, 0); PG8_LDB(B1, 1, 1); PG8_SCHED; PG8_LDA(At, 1, 0); PG8_STAGE(PG8_SA(0, 1), a2 + hstep, voffA);
            PG8_WAIT_V(8); PG8_WAIT_L(0); PG8_BAR; PG8_MMA(0, 0, At, B0); PG8_MMA(0, 1, At, B1); PG8_BAR; PG8_SCHED;
            PG8_LDA(At, 1, 1); PG8_STAGE(PG8_SB(1, 0), b3, voffB); PG8_STAGE(PG8_SB(1, 1), b3 + hstepB, voffB); PG8_STAGE(PG8_SA(1, 0), a3, voffA);
            PG8_WAIT_V(8); PG8_WAIT_L(0); PG8_BAR; PG8_MMA(1, 0, At, B0); PG8_MMA(1, 1, At, B1); PG8_BAR; PG8_SCHED;
        }
        if (wr == 0) PG8_BAR;
        E(acc, cur, wr, wc, fr, fq, (LAS float*)(lds + EPI_SCR_OFF));
        if (!has_next) break;
#pragma unroll
        for (int a = 0; a < 2; ++a)
#pragma unroll
            for (int b = 0; b < 2; ++b)
#pragma unroll
                for (int m = 0; m < 4; ++m)
#pragma unroll
                    for (int n = 0; n < 2; ++n) acc[a][b][m][n] = (f32x4){0.f, 0.f, 0.f, 0.f};
        cur = nxt; cA = nA; cB = nB; ++ui;
        if (wr == 1) PG8_BAR;
    }
    PG8_WAIT_V(0);
    PG8_BAR;
#undef PG8_SA
#undef PG8_SB
#undef PG8_STAGE
#undef PG8_LDA
#undef PG8_LDB
#undef PG8_MMA
#undef PG8_WAIT_V
#undef PG8_WAIT_L
#undef PG8_BAR
#undef PG8_SCHED
}

typedef f32x4 Acc[2][2][4][2];

struct EpiP1 {
    bf16_t *QA, *G, *VT; const float *GN, *bgate;
    __device__ __forceinline__ void operator()(Acc& acc, const Unit& u, int wr, int wc, int fr, int fq, LAS float* scr) const {
        const int colw = 64 * wc + 8 * fq, rowl = wr * 64 + fr;
        if (u.sel == 1) {
            const int tok0 = u.pn * BM + colw;
#pragma unroll
            for (int ai = 0; ai < 2; ++ai)
#pragma unroll
                for (int m = 0; m < 4; ++m) { const int vd = u.pm * BM + rowl + ai * HALF + m * 16;
#pragma unroll
                    for (int bj = 0; bj < 2; ++bj) { const int tok = tok0 + 32 * bj;
                        *(u32x4*)(VT + ((size_t)((vd >> 7) * 128 + (tok >> 6)) * 8192 + (vd & 127) * 64 + (tok & 63))) = pack8(acc[ai][bj][m][0], acc[ai][bj][m][1]); } }
            return;
        }
        if (u.pn >= 16) {
            const int gcol = (u.pn - 16) * BM + colw;
            f32x4 bv[2][2];
#pragma unroll
            for (int bj = 0; bj < 2; ++bj)
#pragma unroll
                for (int n = 0; n < 2; ++n) bv[bj][n] = *(const f32x4*)(bgate + gcol + 32 * bj + 4 * n);
            bf16_t* base = G + (size_t)(u.pm * BM + rowl) * 4096 + gcol;
#pragma unroll
            for (int ai = 0; ai < 2; ++ai)
#pragma unroll
                for (int m = 0; m < 4; ++m) { bf16_t* rp = base + (size_t)(ai * HALF + m * 16) * 4096;
#pragma unroll
                    for (int bj = 0; bj < 2; ++bj) { f32x4 v[2];
#pragma unroll
                        for (int n = 0; n < 2; ++n)
#pragma unroll
                            for (int j = 0; j < 4; ++j) { const float z = acc[ai][bj][m][n][j] + bv[bj][n][j]; v[n][j] = fast_rcp(1.f + fast_exp2(-z * LOG2E)); }
                        *(u32x4*)(rp + 32 * bj) = pack8(v[0], v[1]); } }
            return;
        }
        const int t = u.pn >> 2; const bool fox = t >= 2;
        bf16_t* O = QA + (size_t)t * (8u << 20);
        const float* gn = GN + t * 128;
        const int d0 = (fox ? 64 * (wc & 1) : 0) + 8 * fq;
        f32x4 gv[2][2];
#pragma unroll
        for (int bj = 0; bj < 2; ++bj)
#pragma unroll
            for (int n = 0; n < 2; ++n) gv[bj][n] = *(const f32x4*)(gn + d0 + 32 * bj + 4 * n);
        float ss[2][4];
#pragma unroll
        for (int ai = 0; ai < 2; ++ai)
#pragma unroll
            for (int m = 0; m < 4; ++m) { float s = 0.f;
#pragma unroll
                for (int bj = 0; bj < 2; ++bj)
#pragma unroll
                    for (int n = 0; n < 2; ++n) { const f32x4 x = acc[ai][bj][m][n]; s += (x[0] * x[0] + x[1] * x[1]) + (x[2] * x[2] + x[3] * x[3]); }
                s += __shfl_xor(s, 16); s += __shfl_xor(s, 32); ss[ai][m] = s; }
        if (fox) {
            if (fq == 0) {
#pragma unroll
                for (int ai = 0; ai < 2; ++ai)
#pragma unroll
                    for (int m = 0; m < 4; ++m) scr[(ai * HALF + rowl + m * 16) * 4 + wc] = ss[ai][m];
            }
            LDS_WAIT(); __builtin_amdgcn_s_barrier(); asm volatile("" ::: "memory");
#pragma unroll
            for (int ai = 0; ai < 2; ++ai)
#pragma unroll
                for (int m = 0; m < 4; ++m) ss[ai][m] += scr[(ai * HALF + rowl + m * 16) * 4 + (wc ^ 1)];
            LDS_WAIT();
        }
        const float inv = fox ? (1.f / 128.f) : (1.f / 64.f);
        const bool isk = (t & 1) != 0; const int wsh = fox ? 7 : 6;
#pragma unroll
        for (int ai = 0; ai < 2; ++ai)
#pragma unroll
            for (int m = 0; m < 4; ++m) { const float rinv = fast_rsq(ss[ai][m] * inv + EPS); const int tok = u.pm * BM + rowl + ai * HALF + m * 16;
#pragma unroll
                for (int bj = 0; bj < 2; ++bj) { const f32x4 v0 = acc[ai][bj][m][0] * rinv * gv[bj][0], v1 = acc[ai][bj][m][1] * rinv * gv[bj][1];
                    const int col = (u.pn & 3) * BM + colw + 32 * bj;
                    const size_t off = isk ? ((size_t)((col >> wsh) * 128 + (tok >> 6)) << (6 + wsh)) + ((tok & 63) << wsh) + (col & ((1 << wsh) - 1)) : (size_t)tok * 1024 + col;
                    *(u32x4*)(O + off) = pack8(v0, v1); } }
    }
};

struct EpiP3 {
    const bf16_t* G; bf16_t* MGT; bf16_t* MG;
    __device__ __forceinline__ void operator()(Acc& acc, const Unit& u, int wr, int wc, int fr, int fq, LAS float*) const {
        const int col = u.pn * BM + 64 * wc + 8 * fq, row0 = u.pm * BM + wr * 64 + fr;
#pragma unroll
        for (int ai = 0; ai < 2; ++ai)
#pragma unroll
            for (int m = 0; m < 4; ++m) { const size_t row = (size_t)(row0 + ai * HALF + m * 16);
#pragma unroll
                for (int bj = 0; bj < 2; ++bj) { const int c = col + 32 * bj;
                    const u32x4 gw = *(const u32x4*)(G + row * 4096 + (u.sel ? 2048 : 0) + c);
                    const f32x4 g0 = {bf_lo(gw.x), bf_hi(gw.x), bf_lo(gw.y), bf_hi(gw.y)}, g1 = {bf_lo(gw.z), bf_hi(gw.z), bf_lo(gw.w), bf_hi(gw.w)};
                    f32x4 v0 = acc[ai][bj][m][0] * g0, v1 = acc[ai][bj][m][1] * g1;
                    bf16_t* tp = MGT + row * DM + c;
                    if (u.sel == 0) { *(u32x4*)tp = pack8(v0, v1); }
                    else { const u32x4 tw = *(const u32x4*)tp;
                        v0 += (f32x4){bf_lo(tw.x), bf_hi(tw.x), bf_lo(tw.y), bf_hi(tw.y)}; v1 += (f32x4){bf_lo(tw.z), bf_hi(tw.z), bf_lo(tw.w), bf_hi(tw.w)};
                        *(u32x4*)(MG + row * DM + c) = pack8(v0, v1); } } }
    }
};

struct EpiP4 {
    const float* x; bf16_t* X1B; float* SS2;
    __device__ __forceinline__ void operator()(Acc& acc, const Unit& u, int wr, int wc, int fr, int fq, LAS float*) const {
        const int col = u.pn * BM + 64 * wc + 8 * fq, row0 = u.pm * BM + wr * 64 + fr;
#pragma unroll
        for (int ai = 0; ai < 2; ++ai)
#pragma unroll
            for (int m = 0; m < 4; ++m) { const size_t row = (size_t)(row0 + ai * HALF + m * 16); float s = 0.f;
#pragma unroll
                for (int bj = 0; bj < 2; ++bj) { const size_t o = row * DM + col + 32 * bj;
                    const f32x4 v0 = acc[ai][bj][m][0] + *(const f32x4*)(x + o), v1 = acc[ai][bj][m][1] + *(const f32x4*)(x + o + 4);
                    *(u32x4*)(X1B + o) = pack8(v0, v1);
                    s += (v0[0] * v0[0] + v0[1] * v0[1]) + (v0[2] * v0[2] + v0[3] * v0[3]) + (v1[0] * v1[0] + v1[1] * v1[1]) + (v1[2] * v1[2] + v1[3] * v1[3]); }
                s += __shfl_xor(s, 16); s += __shfl_xor(s, 32);
                if (fq == 0) SS2[row * 32 + u.pn * 4 + wc] = s; }
    }
};

struct EpiP5 {
    const float* SS2; bf16_t* U; int pm0;
    __device__ __forceinline__ void operator()(Acc& acc, const Unit& u, int wr, int wc, int fr, int fq, LAS float* scr) const {
        const int col = u.pn * BM + 64 * wc + 8 * fq, row0 = u.pm * BM + wr * 64 + fr;
#pragma unroll
        for (int ai = 0; ai < 2; ++ai)
#pragma unroll
            for (int m = 0; m < 4; ++m) { const size_t row = (size_t)(row0 + ai * HALF + m * 16);
                float rinv;
                if (u.pm == pm0) rinv = scr[wr * 64 + fr + ai * HALF + m * 16];
                else { const f32x4* sp = (const f32x4*)(SS2 + row * 32); f32x4 sa = sp[0];
#pragma unroll
                    for (int q = 1; q < 8; ++q) sa += sp[q];
                    rinv = fast_rsq(((sa[0] + sa[1]) + (sa[2] + sa[3])) * (1.f / DM) + EPS); }
#pragma unroll
                for (int bj = 0; bj < 2; ++bj) { f32x4 v[2];
#pragma unroll
                    for (int n = 0; n < 2; ++n)
#pragma unroll
                        for (int j = 0; j < 4; ++j) { const float z = fmaxf(acc[ai][bj][m][n][j] * rinv, 0.f); v[n][j] = z * z; }
                    *(u32x4*)(U + row * FF + col + 32 * bj) = pack8(v[0], v[1]); } }
    }
};

struct EpiP6 {
    const bf16_t* X1B; float* out;
    __device__ __forceinline__ void operator()(Acc& acc, const Unit& u, int wr, int wc, int fr, int fq, LAS float*) const {
        const int col = u.pn * BM + 64 * wc + 8 * fq, row0 = u.pm * BM + wr * 64 + fr;
#pragma unroll
        for (int ai = 0; ai < 2; ++ai)
#pragma unroll
            for (int m = 0; m < 4; ++m) { const size_t row = (size_t)(row0 + ai * HALF + m * 16);
#pragma unroll
                for (int bj = 0; bj < 2; ++bj) { const size_t o = row * DM + col + 32 * bj; const u32x4 xw = *(const u32x4*)(X1B + o);
                    const f32x4 v0 = acc[ai][bj][m][0] + (f32x4){bf_lo(xw.x), bf_hi(xw.x), bf_lo(xw.y), bf_hi(xw.y)}, v1 = acc[ai][bj][m][1] + (f32x4){bf_lo(xw.z), bf_hi(xw.z), bf_lo(xw.w), bf_hi(xw.w)};
                    *(f32x4*)(out + o) = v0; *(f32x4*)(out + o + 4) = v1; } }
    }
};
}

__device__ __forceinline__ void transpose_item(const float* __restrict__ W, int ld, int col0, int ncols, int K, bf16_t* WT, int row_off, LAS float* scr, int item, int lane) {
    const int nblk = ncols / 32, kb = item / nblk, nb = item % nblk, k0 = 64 * kb, n0 = 32 * nb;
    const float* wp = W + (size_t)(k0 + (lane >> 5)) * ld + col0 + n0 + (lane & 31);
    LAS float* sp = scr + (lane >> 5) * 33 + (lane & 31);
#pragma unroll 4
    for (int i = 0; i < 32; ++i) { sp[i * 66] = *wp; wp += 2 * ld; }
    LDS_WAIT();
    const int c = lane & 7;
#pragma unroll
    for (int j = 0; j < 4; ++j) { const int n = (lane >> 3) + 8 * j; const LAS float* s = scr + (8 * c) * 33 + n;
        u32x4 o; o.x = cvt_pk_bf16(s[0 * 33], s[1 * 33]); o.y = cvt_pk_bf16(s[2 * 33], s[3 * 33]); o.z = cvt_pk_bf16(s[4 * 33], s[5 * 33]); o.w = cvt_pk_bf16(s[6 * 33], s[7 * 33]);
        *(u32x4*)(WT + (size_t)(row_off + n0 + n) * K + k0 + 8 * c) = o; }
    LDS_WAIT();
}

__device__ __forceinline__ void transpose_item64(const float* __restrict__ W, int ld, int ncols, int K, bf16_t* WT, LAS float* scr, int item, int lane, const float* ks = nullptr) {
    const int nblk = ncols / 64, kb = item / nblk, nb = item % nblk, k0 = 64 * kb, n0 = 64 * nb;
    const float* wp = W + (size_t)(k0 + (lane >> 4)) * ld + n0 + 4 * (lane & 15);
    f32x4 v[16];
#pragma unroll
    for (int i = 0; i < 16; ++i) v[i] = *(const f32x4*)(wp + (size_t)(4 * i) * ld);
    if (ks) {
#pragma unroll
        for (int i = 0; i < 16; ++i) v[i] = v[i] * ks[k0 + 4 * i + (lane >> 4)]; }
    LAS float* sp = scr + (lane >> 4) * 65 + 4 * (lane & 15);
#pragma unroll
    for (int i = 0; i < 16; ++i) { sp[(4 * i) * 65 + 0] = v[i][0]; sp[(4 * i) * 65 + 1] = v[i][1]; sp[(4 * i) * 65 + 2] = v[i][2]; sp[(4 * i) * 65 + 3] = v[i][3]; }
    LDS_WAIT();
    const int c = lane >> 3;
#pragma unroll
    for (int j = 0; j < 8; ++j) { const int n = (lane & 7) + 8 * j; const LAS float* s = scr + (8 * c) * 65 + n;
        u32x4 o; o.x = cvt_pk_bf16(s[0 * 65], s[1 * 65]); o.y = cvt_pk_bf16(s[2 * 65], s[3 * 65]); o.z = cvt_pk_bf16(s[4 * 65], s[5 * 65]); o.w = cvt_pk_bf16(s[6 * 65], s[7 * 65]);
        *(u32x4*)(WT + (size_t)(n0 + n) * K + k0 + 8 * c) = o; }
    LDS_WAIT();
}

namespace att {
constexpr int VROW = 144, BUF = 36864;
static_assert(2 * BUF <= GEMM_LDS, "attention LDS map");
#define MFMA32(a, b, c) __builtin_amdgcn_mfma_f32_32x32x16_bf16((a), (b), (c), 0, 0, 0)

__device__ __forceinline__ void pack_p(const f32x16& S, bf16x8 (&pf)[2]) {
#pragma unroll
    for (int s = 0; s < 2; ++s) { u32x4 p; p.x = cvt_pk_bf16(S[8 * s + 0], S[8 * s + 1]); p.y = cvt_pk_bf16(S[8 * s + 2], S[8 * s + 3]); p.z = cvt_pk_bf16(S[8 * s + 4], S[8 * s + 5]); p.w = cvt_pk_bf16(S[8 * s + 6], S[8 * s + 7]);
        pf[s] = __builtin_bit_cast(bf16x8, p); }
}
constexpr float PRUNE_THR = 80.f;
template <bool DIFF>
__device__ __forceinline__ void attn_unit(LAS unsigned char* lds, const bf16_t* __restrict__ Q, const bf16_t* __restrict__ Kg, const bf16_t* __restrict__ Vt, const float* __restrict__ c2g,
                                          bf16_t* Og, float* Of, int head, int qb, int mp, float lam, const float* GN) {
    constexpr int NX = DIFF ? 4 : 8, KROW = DIFF ? 144 : 272, V_OFF = 64 * KROW, C2_OFF = V_OFF + 128 * VROW;
    static_assert(C2_OFF + 256 <= BUF, "attention buffer");
    const int tid = threadIdx.x, lane = tid & 63, w = __builtin_amdgcn_readfirstlane(tid >> 6), r = lane & 31, h = lane >> 5;
    const int trow = qb * 256 + 32 * w + r;
    const int jmax = 4 * qb + 3, jd = 4 * qb + (w >> 1);
    const int toff = 32 * (w & 1) + r;
    const float slope2 = DIFF ? exp2f(-(float)(head + 1)) * LOG2E : 0.f;
    const bf16_t* gV = Vt + (size_t)head * 128 * 8192 + tid * 8;
    const unsigned lV = V_OFF + (tid >> 3) * VROW + (tid & 7) * 16;
    const unsigned lK = DIFF ? (tid >> 3) * KROW + (tid & 7) * 16 : (tid >> 4) * KROW + (tid & 15) * 16;
    const int kap = (r & ~12) | ((r & 4) << 1) | ((r & 8) >> 1);
    const unsigned rK = kap * KROW + 16 * h, rV = V_OFF + r * VROW + 16 * h;
    f32x16 O[4];
    int jmin = 0;
    if (DIFF) {
        float gq = fabsf(GN[lane]), gk = fabsf(GN[128 + lane]);
#pragma unroll
        for (int o = 1; o < 64; o <<= 1) { gq = fmaxf(gq, __shfl_xor(gq, o)); gk = fmaxf(gk, __shfl_xor(gk, o)); }
        const float B2 = 2.f * 1.05f * 64.f * gq * gk;
        const float dmax = (PRUNE_THR + B2) / slope2;
        const float jf = ceilf(((float)(256 * qb - 63) - dmax) * (1.f / 64.f));
        jmin = jf > 0.f ? (int)jf : 0;
    } else {
        float gq = fmaxf(fabsf(GN[256 + lane]), fabsf(GN[320 + lane])), gk = fmaxf(fabsf(GN[384 + lane]), fabsf(GN[448 + lane]));
#pragma unroll
        for (int o = 1; o < 64; o <<= 1) { gq = fmaxf(gq, __shfl_xor(gq, o)); gk = fmaxf(gk, __shfl_xor(gk, o)); }
        const float B2 = 2.f * 1.05f * 128.f * gq * gk;
        const float cref = c2g[head * SEQ + 256 * qb];
        const int j0 = lane, j1 = lane + 64;
        const bool n0 = (j0 <= jmax) && (B2 + c2g[head * SEQ + 64 * (j0 <= jmax ? j0 : 0) + 63] - cref >= -PRUNE_THR);
        const bool n1 = (j1 <= jmax) && (B2 + c2g[head * SEQ + 64 * (j1 <= jmax ? j1 : 0) + 63] - cref >= -PRUNE_THR);
        const unsigned long long b0 = __ballot(n0), b1 = __ballot(n1);
        jmin = b0 ? (__ffsll((long long)b0) - 1) : (b1 ? 64 + __ffsll((long long)b1) - 1 : 4 * qb);
        if (jmin > 4 * qb) jmin = 4 * qb;
    }
    jmin = __builtin_amdgcn_readfirstlane(jmin);
    {
        bf16x8 qf[NX];
        { const bf16_t* qp = Q + (size_t)trow * 1024 + head * 128 + (DIFF ? 64 * mp : 0) + 8 * h;
#pragma unroll
          for (int x = 0; x < NX; ++x) qf[x] = *(const bf16x8*)(qp + 16 * x);
#pragma unroll
          for (int x = 0; x < NX; ++x) asm volatile("" : "+v"(qf[x])); }
        const bf16_t* gK = DIFF ? Kg + (size_t)(head * 2 + mp) * 128 * 4096 + tid * 8 : Kg + (size_t)head * 128 * 8192 + tid * 8;
        u32x4 kreg[2], vreg[2]; float creg = 0.f;
#define ATT_LOAD(j) do { const size_t j_ = (size_t)(j); kreg[0] = *(const u32x4*)(gK + j_ * (DIFF ? 4096 : 8192)); if (!DIFF) kreg[1] = *(const u32x4*)(gK + j_ * 8192 + 4096); \
        vreg[0] = *(const u32x4*)(gV + j_ * 8192); vreg[1] = *(const u32x4*)(gV + j_ * 8192 + 4096); if (!DIFF && tid < 64) creg = c2g[head * SEQ + j_ * 64 + tid]; } while (0)
#define ATT_WRITE(b) do { LAS unsigned char* bp_ = lds + (b) * BUF; *(LAS u32x4*)(bp_ + lK) = kreg[0]; if (!DIFF) *(LAS u32x4*)(bp_ + lK + 32 * KROW) = kreg[1]; \
        *(LAS u32x4*)(bp_ + lV) = vreg[0]; *(LAS u32x4*)(bp_ + lV + 64 * VROW) = vreg[1]; if (!DIFF && tid < 64) *(LAS float*)(bp_ + C2_OFF + tid * 4) = creg; } while (0)
#pragma unroll
        for (int db = 0; db < 4; ++db)
#pragma unroll
            for (int i = 0; i < 16; ++i) O[db][i] = 0.f;
        float m = DIFF ? slope2 * (float)toff : c2g[head * SEQ + trow], l = 0.f;
        asm volatile("" : "+v"(m));
        ATT_LOAD(jmax); ATT_WRITE(0);
        __syncthreads();
        int cur = 0;
        for (int j = jmax; j >= jmin; --j) {
            if (j > jd) { if (j > jmin) ATT_LOAD(j - 1); }
            if (j <= jd) {
                const bool diag = (j == jd);
                const LAS unsigned char* bp = lds + cur * BUF;
                if (__any(l > 1.8446744e19f)) {
                    const float a = 5.421010862e-20f; l *= a; m += 64.f;
#pragma unroll
                    for (int db = 0; db < 4; ++db) O[db] *= a;
                }
                if (DIFF && !diag) m += 64.f * slope2;
                f32x16 S0, S1;
                bf16x8 kfa[NX], kfb[DIFF ? NX : 1];
#pragma unroll
                for (int x = 0; x < NX; ++x) { kfa[x] = *(const LAS bf16x8*)(bp + rK + x * 32); if (DIFF) kfb[x] = *(const LAS bf16x8*)(bp + rK + 32 * KROW + x * 32); }
                asm volatile("" ::: "memory");
                if (DIFF) {
                    if (diag) { int toff_v = toff, h_v = 8 * h; asm volatile("" : "+v"(toff_v), "+v"(h_v)); const float tf = (float)toff_v, hf = (float)h_v, base = slope2 * tf - m;
#pragma unroll
                        for (int i = 0; i < 16; ++i) { const float ko = (float)(16 * (i >> 3) + (i & 7)) + hf; S0[i] = base - slope2 * fabsf(ko - tf); S1[i] = base - slope2 * fabsf(ko + 32.f - tf); } }
                    else { const float base = slope2 * (float)(8 * h) - m;
#pragma unroll
                        for (int i = 0; i < 16; ++i) { S0[i] = fmaf(slope2, (float)(16 * (i >> 3) + (i & 7)), base); S1[i] = fmaf(slope2, (float)(32 + 16 * (i >> 3) + (i & 7)), base); } }
                } else {
                    const LAS f32x4* cp = (const LAS f32x4*)(bp + C2_OFF + (8 * h) * 4);
                    const f32x4 c0 = cp[0], c1 = cp[1], c2v = cp[4], c3 = cp[5], d0 = cp[8], d1 = cp[9], d2 = cp[12], d3 = cp[13];
#pragma unroll
                    for (int i = 0; i < 4; ++i) { S0[i] = c0[i] - m; S0[4 + i] = c1[i] - m; S0[8 + i] = c2v[i] - m; S0[12 + i] = c3[i] - m;
                                                  S1[i] = d0[i] - m; S1[4 + i] = d1[i] - m; S1[8 + i] = d2[i] - m; S1[12 + i] = d3[i] - m; }
                }
                __builtin_amdgcn_s_setprio(2);
                if (DIFF) {
#pragma unroll
                    for (int x = 0; x < NX; ++x) { S0 = MFMA32(kfa[x], qf[x], S0); S1 = MFMA32(kfb[x], qf[x], S1); }
                } else {
#pragma unroll
                    for (int x = 0; x < NX; ++x) S0 = MFMA32(kfa[x], qf[x], S0);
#pragma unroll
                    for (int x = 0; x < NX; ++x) kfa[x] = *(const LAS bf16x8*)(bp + rK + 32 * KROW + x * 32);
                    asm volatile("" ::: "memory");
#pragma unroll
                    for (int x = 0; x < NX; ++x) S1 = MFMA32(kfa[x], qf[x], S1);
                }
                if (j > jmin) ATT_LOAD(j - 1);
                bf16x8 vf0[8], vf1[8];
#pragma unroll
                for (int s = 0; s < 2; ++s)
#pragma unroll
                    for (int db = 0; db < 4; ++db) vf0[s * 4 + db] = *(const LAS bf16x8*)(bp + rV + db * 32 * VROW + s * 32);
                asm volatile("" ::: "memory");
                if (diag) {
                    if (!DIFF) { int toff_v = toff - 8 * h; asm volatile("" : "+v"(toff_v));
#pragma unroll
                        for (int i = 0; i < 16; ++i) { const int ko = 16 * (i >> 3) + (i & 7); if (ko > toff_v) S0[i] = -INFINITY; if (ko + 32 > toff_v) S1[i] = -INFINITY; } }
                    float tm = S0[0];
#pragma unroll
                    for (int i = 1; i < 16; ++i) tm = fmaxf(tm, S0[i]);
#pragma unroll
                    for (int i = 0; i < 16; ++i) tm = fmaxf(tm, S1[i]);
                    tm = fmaxf(tm, __shfl_xor(tm, 32));
                    m += tm;
#pragma unroll
                    for (int i = 0; i < 16; ++i) { S0[i] -= tm; S1[i] -= tm; }
                }
                bf16x8 pf0[2], pf1[2];
                float ls = 0.f;
#pragma unroll
                for (int i = 0; i < 16; ++i) { S0[i] = fast_exp2(S0[i]); ls += S0[i]; }
                pack_p(S0, pf0);
#pragma unroll
                for (int s = 0; s < 2; ++s)
#pragma unroll
                    for (int db = 0; db < 4; ++db) O[db] = MFMA32(vf0[s * 4 + db], pf0[s], O[db]);
#pragma unroll
                for (int s = 0; s < 2; ++s)
#pragma unroll
                    for (int db = 0; db < 4; ++db) vf1[s * 4 + db] = *(const LAS bf16x8*)(bp + rV + db * 32 * VROW + 64 + s * 32);
                asm volatile("" ::: "memory");
#pragma unroll
                for (int i = 0; i < 16; ++i) { S1[i] = fast_exp2(S1[i]); ls += S1[i]; }
                pack_p(S1, pf1);
                l += ls;
#pragma unroll
                for (int s = 0; s < 2; ++s)
#pragma unroll
                    for (int db = 0; db < 4; ++db) O[db] = MFMA32(vf1[s * 4 + db], pf1[s], O[db]);
                __builtin_amdgcn_s_setprio(0);
            }
            if (j > jmin) ATT_WRITE(cur ^ 1);
            __syncthreads();
            cur ^= 1;
        }
        l += __shfl_xor(l, 32);
        const float il = (DIFF && mp == 1) ? -lam / l : 1.f / l;
#pragma unroll
        for (int db = 0; db < 4; ++db) O[db] *= il;
#undef ATT_LOAD
#undef ATT_WRITE
    }
    asm volatile("" ::: "memory");
    bf16_t* op = Og + (DIFF ? (size_t)mp * ((size_t)SEQ * 1024) : (size_t)0) + (size_t)trow * 1024 + head * 128 + 4 * h;
#pragma unroll
    for (int db = 0; db < 4; ++db)
#pragma unroll
        for (int g = 0; g < 4; ++g) { u32x2 o; o.x = cvt_pk_bf16(O[db][4 * g], O[db][4 * g + 1]); o.y = cvt_pk_bf16(O[db][4 * g + 2], O[db][4 * g + 3]);
            *(u32x2*)(op + 32 * db + 8 * g) = o; }
}
}

#define XB_TMO      128
#define XB_XCNT(j)  (256  + 64 * (j))
#define XB_XSUB(j)  (1280 + 64 * (j))
#define XB_XGEN(j)  (2304 + 64 * (j))
#define XB_TOP      3328
#define XB_TOPGEN   3392
#define XCD_BAR_WORDS 3456
#define XB_SPIN_CAP (1u << 22)
__device__ __forceinline__ unsigned xb_ld(unsigned* p)              { return __hip_atomic_load(p, __ATOMIC_RELAXED, __HIP_MEMORY_SCOPE_AGENT); }
__device__ __forceinline__ unsigned xb_add(unsigned* p, unsigned v) { return __hip_atomic_fetch_add(p, v, __ATOMIC_RELAXED, __HIP_MEMORY_SCOPE_AGENT); }
__device__ __forceinline__ unsigned xb_xcc_id() { return (unsigned)__builtin_amdgcn_s_getreg((3 << 11) | 20) & 0xFu; }
#define XB_SPIN(cond, bar) do { unsigned _sp = 0; while (cond) { __builtin_amdgcn_s_sleep(1); \
    if ((++_sp & 255u) == 0u) { if (xb_ld(&(bar)[XB_TMO])) break; if (_sp > XB_SPIN_CAP) { atomicAdd(&(bar)[XB_TMO], 1u); break; } } } } while (0)
struct XcdBarrier { unsigned* bar; unsigned x; volatile LAS unsigned* st; };
__device__ __forceinline__ XcdBarrier xcd_barrier_post(unsigned* bar, volatile LAS unsigned* st) {
    XcdBarrier b; b.bar = bar; b.x = xb_xcc_id(); b.st = st;
    if (threadIdx.x == 0) (void)xb_add(&bar[XB_XCNT(b.x)], 1u);
    return b;
}
__device__ __forceinline__ void xcd_barrier_complete(unsigned* bar, unsigned x, unsigned& nloc, unsigned& nx) {
    const unsigned G = gridDim.x * gridDim.y * gridDim.z;
    unsigned sum, cnt, mine, sp = 0u;
    for (;;) {
        sum = 0u; cnt = 0u; mine = 0u;
#pragma unroll
        for (unsigned j = 0; j < 16; ++j) { const unsigned c = xb_ld(&bar[XB_XCNT(j)]); sum += c; cnt += (c > 0u) ? 1u : 0u; mine = (j == x) ? c : mine; }
        if (sum == G) break;
        __builtin_amdgcn_s_sleep(1);
        if ((++sp & 255u) == 0u) { if (xb_ld(&bar[XB_TMO])) break; if (sp > XB_SPIN_CAP) { atomicAdd(&bar[XB_TMO], 1u); break; } }
    }
    nloc = mine > 0u ? mine : 1u; nx = cnt > 0u ? cnt : 1u;
}
__device__ __forceinline__ void xcd_barrier(const XcdBarrier& b) {
    asm volatile("s_waitcnt vmcnt(0)" ::: "memory");
    __syncthreads();
    if (threadIdx.x == 0) {
        unsigned* bar = b.bar;
        __builtin_amdgcn_s_waitcnt(0);
        unsigned nloc = b.st[0], nx = b.st[1];
        if (nloc == 0u) { xcd_barrier_complete(bar, b.x, nloc, nx); b.st[0] = nloc; b.st[1] = nx; }
        const unsigned old = xb_add(&bar[XB_XSUB(b.x)], 1u);
        const unsigned gen = old / nloc;
        if (old + 1u == (gen + 1u) * nloc) {
            __builtin_amdgcn_fence(__ATOMIC_RELEASE, "agent");
            asm volatile("s_waitcnt vmcnt(0)" ::: "memory");
            const unsigned og = xb_add(&bar[XB_TOP], 1u);
            const unsigned tg = og / nx;
            if (og + 1u == (tg + 1u) * nx) xb_add(&bar[XB_TOPGEN], 1u);
            else XB_SPIN(xb_ld(&bar[XB_TOPGEN]) == tg, bar);
            __builtin_amdgcn_fence(__ATOMIC_ACQUIRE, "agent");
            xb_add(&bar[XB_XGEN(b.x)], 1u);
            asm volatile("s_waitcnt vmcnt(0)" ::: "memory");
        } else {
            XB_SPIN(xb_ld(&bar[XB_XGEN(b.x)]) == gen, bar);
            __builtin_amdgcn_fence(__ATOMIC_ACQUIRE, "agent");
            asm volatile("s_waitcnt vmcnt(0)" ::: "memory");
        }
    }
    __syncthreads();
}

struct Args { const float* in[21]; float* out; unsigned char* ws; int ph_lo, ph_hi, att_sel, pad; };

__global__ void __launch_bounds__(NTHREADS, 2) fwd_kernel(Args args) {
    extern __shared__ __attribute__((aligned(16))) unsigned char lds_raw[];
    LAS unsigned char* lds = (LAS unsigned char*)lds_raw;
    const int tid = threadIdx.x, lane = tid & 63, wave = __builtin_amdgcn_readfirstlane(tid >> 6);
    const int G = gridDim.x, bx = blockIdx.x;
    const int vcu = (G % 8 == 0) ? (bx % 8) * (G / 8) + bx / 8 : bx;
    unsigned char* ws = args.ws;
    const float* x = args.in[0];       const float* norm_mix = args.in[1]; const float* w_in = args.in[2];   const float* b_forget = args.in[3];
    const float* qn_diff = args.in[4]; const float* kn_diff = args.in[5];  const float* lq1 = args.in[6];    const float* lk1 = args.in[7];
    const float* lq2 = args.in[8];     const float* lk2 = args.in[9];      const float* subln = args.in[10]; const float* qn_fox = args.in[11];
    const float* kn_fox = args.in[12]; const float* w_bd = args.in[13];    const float* w_bf = args.in[14];  const float* w_gate = args.in[15];
    const float* b_gate = args.in[16]; const float* w_out = args.in[17];   const float* norm_mlp = args.in[18]; const float* w_up = args.in[19];
    const float* w_down = args.in[20];
    float* out = args.out;
    float* LF = (float*)(ws + WS_LF); float* C2 = (float*)(ws + WS_C2); float* SS2 = (float*)(ws + WS_SS2); float* GN = (float*)(ws + WS_GN);
    bf16_t *Wbd = (bf16_t*)(ws + WS_WBD), *Wbf = (bf16_t*)(ws + WS_WBF), *Wout = (bf16_t*)(ws + WS_WOUT), *Wt1 = (bf16_t*)(ws + WS_WT1), *Wt2 = (bf16_t*)(ws + WS_WT2);
    bf16_t *Wup = (bf16_t*)(ws + WS_WUP), *Wdown = (bf16_t*)(ws + WS_WDOWN), *H = (bf16_t*)(ws + WS_H);
    bf16_t *QA = (bf16_t*)(ws + WS_QA), *KA = (bf16_t*)(ws + WS_KA), *QB = (bf16_t*)(ws + WS_QB), *KB = (bf16_t*)(ws + WS_KB), *VT = (bf16_t*)(ws + WS_VT);
    bf16_t *Gt = (bf16_t*)(ws + WS_G), *OA = (bf16_t*)(ws + WS_OA), *OB = (bf16_t*)(ws + WS_OB), *MG = (bf16_t*)(ws + WS_MG), *XG = (bf16_t*)(ws + WS_XG), *U = (bf16_t*)(ws + WS_U);
    bf16_t* MGT = (bf16_t*)(ws + WS_MGT);
    const int lo = args.ph_lo, hi = args.ph_hi;
    const int gw = vcu * NWAVES + wave, NGW = G * NWAVES;
#ifndef PH_MASK
#define PH_MASK 0xff
#endif
#define IN(k) (((PH_MASK >> (k)) & 1) && lo <= (k) && (k) < hi)
#define SEAM(k) do { if (IN(k) && IN((k) + 1)) { if (args.pad != 0) cg::this_grid().sync(); else xcd_barrier(xbar); } } while (0)
    XcdBarrier xbar; xbar.bar = (unsigned*)(ws + WS_CTL) + 1024; xbar.x = 0; xbar.st = (volatile LAS unsigned*)(lds + LDS_BAR_OFF);
    if (hi - lo > 1) {
        if (tid < 2) ((volatile LAS unsigned*)(lds + LDS_BAR_OFF))[tid] = 0u;
        __syncthreads();
        xbar = xcd_barrier_post((unsigned*)(ws + WS_CTL) + 1024, (volatile LAS unsigned*)(lds + LDS_BAR_OFF));
    }

    if (IN(0)) {
        LAS float* scr = (LAS float*)(lds + wave * P0_SCR_STRIDE);
        LAS float* wf = (LAS float*)(lds + P0_WF_OFF);
        if (bx == 0) { if (tid < 64) { GN[tid] = qn_diff[tid] * (0.125f * LOG2E); GN[128 + tid] = kn_diff[tid]; } if (tid < 128) { GN[256 + tid] = qn_fox[tid] * (0.08838834764831845f * LOG2E); GN[384 + tid] = kn_fox[tid]; } }
        for (int k = tid; k < DM; k += NTHREADS) { const f32x4 a = *(const f32x4*)(w_in + (size_t)k * NPROJ + 6144), b = *(const f32x4*)(w_in + (size_t)k * NPROJ + 6148);
            wf[0 * DM + k] = a[0]; wf[1 * DM + k] = a[1]; wf[2 * DM + k] = a[2]; wf[3 * DM + k] = a[3]; wf[4 * DM + k] = b[0]; wf[5 * DM + k] = b[1]; wf[6 * DM + k] = b[2]; wf[7 * DM + k] = b[3]; }
        __syncthreads();
        constexpr int I0 = 2048, I1 = 2048, I2 = 4096, I3 = 1024, I4 = 1024, NIT = I0 + I1 + I2 + I3 + I4;
        for (int it = gw; it < NIT; it += NGW) {
            int q = it;
            if (q < I0) { transpose_item(w_in, NPROJ, 0, 2048, DM, Wt1, 0, scr, q, lane); continue; } q -= I0;
            if (q < I1) { transpose_item(w_in, NPROJ, 3072, 2048, DM, Wt1, 2048, scr, q, lane); continue; } q -= I1;
            if (q < I2) { transpose_item(w_gate, 4096, 0, 4096, DM, Wt1, 4096, scr, q, lane); continue; } q -= I2;
            if (q < I3) { transpose_item(w_in, NPROJ, 2048, 1024, DM, Wt2, 0, scr, q, lane); continue; } q -= I3;
            transpose_item(w_in, NPROJ, 5120, 1024, DM, Wt2, 1024, scr, q, lane);
        }
        for (int row = gw; row < SEQ; row += NGW) {
            const f32x4* xr = (const f32x4*)(x + (size_t)row * DM) + lane;
            f32x4 v[8]; float s = 0.f;
#pragma unroll
            for (int j = 0; j < 8; ++j) { v[j] = xr[64 * j]; s += (v[j][0] * v[j][0] + v[j][1] * v[j][1]) + (v[j][2] * v[j][2] + v[j][3] * v[j][3]); }
            const float rinv = fast_rsq(wave_sum(s) * (1.f / DM) + EPS);
            float a0 = 0.f, a1 = 0.f, a2 = 0.f, a3 = 0.f, a4 = 0.f, a5 = 0.f, a6 = 0.f, a7 = 0.f;
            u32x2* hp = (u32x2*)(H + (size_t)row * DM) + lane;
#pragma unroll
            for (int j = 0; j < 8; ++j) { const f32x4 gg = ((const f32x4*)norm_mix)[lane + 64 * j]; const f32x4 hv = v[j] * rinv * gg;
                u32x2 o; o.x = cvt_pk_bf16(hv[0], hv[1]); o.y = cvt_pk_bf16(hv[2], hv[3]); hp[64 * j] = o;
                const LAS f32x4* wp = (const LAS f32x4*)wf + lane + 64 * j;
#define FDOT(acc_, jj) { const f32x4 w4 = wp[(jj) * (DM / 4)]; acc_ += (hv[0] * w4[0] + hv[1] * w4[1]) + (hv[2] * w4[2] + hv[3] * w4[3]); }
                FDOT(a0, 0) FDOT(a1, 1) FDOT(a2, 2) FDOT(a3, 3) FDOT(a4, 4) FDOT(a5, 5) FDOT(a6, 6) FDOT(a7, 7)
                asm volatile("" ::: "memory");
#undef FDOT
            }
            a0 = wave_sum(a0); a1 = wave_sum(a1); a2 = wave_sum(a2); a3 = wave_sum(a3); a4 = wave_sum(a4); a5 = wave_sum(a5); a6 = wave_sum(a6); a7 = wave_sum(a7);
            if (lane < 8) { float z = lane == 0 ? a0 : lane == 1 ? a1 : lane == 2 ? a2 : lane == 3 ? a3 : lane == 4 ? a4 : lane == 5 ? a5 : lane == 6 ? a6 : a7;
                z += b_forget[lane]; LF[(size_t)lane * SEQ + row] = fminf(z, 0.f) - log1pf(expf(-fabsf(z))); }
        }
        __syncthreads();
    }
    SEAM(0);

    if (IN(1)) {
        {
            pg8::Gemm g{H, Wt2, Wt1, H, DM};
            pg8::P1Order S{G, bx};
            pg8::EpiP1 E{QA, Gt, VT, GN, b_gate};
            pg8::gemm_phase(lds, g, S, E);
        }
        __syncthreads();
        if (bx < 8) {
            LAS double* wsum = (LAS double*)lds;
            const int j = bx; float vals[16]; double s = 0.0;
#pragma unroll
            for (int i = 0; i < 16; ++i) { vals[i] = LF[(size_t)j * SEQ + 16 * tid + i]; s += (double)vals[i]; }
            double inc = s;
#pragma unroll
            for (int o = 1; o < 64; o <<= 1) { const double t = __shfl_up(inc, o); if (lane >= o) inc += t; }
            if (lane == 63) wsum[wave] = inc;
            __syncthreads();
            double run = inc - s;
            for (int q = 0; q < wave; ++q) run += wsum[q];
#pragma unroll
            for (int i = 0; i < 16; ++i) { run += (double)vals[i]; C2[(size_t)j * SEQ + 16 * tid + i] = (float)(-run * (double)LOG2E); }
            __syncthreads();
        }
    }
    SEAM(1);

    if (IN(2)) {
        float lam;
        { const float p1 = wave_sum(lq1[lane] * lk1[lane]), p2 = wave_sum(lq2[lane] * lk2[lane]); lam = expf(p1) - expf(p2) + 0.2f; }
        unsigned* ctl = (unsigned*)(ws + WS_CTL);
        LAS unsigned* qh = (LAS unsigned*)(lds + 8 * 16640 + 64);
        constexpr int TR_IU = 32 * 128, TR_ID = 128 * 32, TR_IB = 16 * 32, TR_IO = 32 * 32, TR_NQ = TR_IU + TR_ID + 2 * TR_IB + TR_IO;
#define TR_ITEM(qq) do { int q_ = (qq); if (q_ < TR_NQ) { \
                if (q_ < TR_IU) transpose_item64(w_up, FF, FF, DM, Wup, scr_, q_, lane_, norm_mlp);     \
                else if ((q_ -= TR_IU) < TR_ID) transpose_item64(w_down, DM, DM, FF, Wdown, scr_, q_, lane_); \
                else if ((q_ -= TR_ID) < TR_IB) transpose_item64(w_bd, DM, DM, 1024, Wbd, scr_, q_, lane_); \
                else if ((q_ -= TR_IB) < TR_IB) transpose_item64(w_bf, DM, DM, 1024, Wbf, scr_, q_, lane_); \
                else transpose_item64(w_out, DM, DM, DM, Wout, scr_, q_ - TR_IB, lane_); } } while (0)
#define TR_DO(it0, n) do { int lane_ = lane, wave_ = wave; asm volatile("" : "+v"(lane_), "+s"(wave_));     \
        LAS float* scr_ = (LAS float*)(lds + wave_ * 16640); \
        for (int rd_ = 0; rd_ < (n); ++rd_) TR_ITEM((it0) + rd_ * NWAVES + wave_); } while (0)
#define TR_ROUNDS(n) do { LAS unsigned* qh2_ = (LAS unsigned*)(lds + 8 * 16640); \
        for (int rd_ = 0; rd_ < (n); ++rd_) { if (tid == 0) *qh2_ = atomicAdd(ctl + 0, (unsigned)NWAVES); __syncthreads(); const int it0_ = (int)*qh2_; __syncthreads(); if (it0_ >= TR_NQ) break; \
            TR_DO(it0_, 1); } } while (0)
#define NEXT_JOB(word, ntr, dst, tr0) do { if (tid == 0) { qh[0] = atomicAdd(ctl + (word), 1u); qh[1] = (args.att_sel == 0) ? atomicAdd(ctl + 0, (unsigned)((ntr) * NWAVES)) : (unsigned)TR_NQ; } \
        __syncthreads(); dst = (int)qh[0]; tr0 = (int)qh[1]; __syncthreads(); } while (0)
#ifndef ATT_SKIP_DIFF
        if (args.att_sel != 2) for (;;) {
            int job, tr0; NEXT_JOB(1, 2, job, tr0);
            if (job < 512) { const int qb = 31 - (job >> 4), r = job & 15;
                att::attn_unit<true>(lds, QA, KA, VT, nullptr, (bf16_t*)out, nullptr, 7 - (r >> 1), qb, r & 1, lam, GN); }
            TR_DO(tr0, 2);
            if (job >= 512) break;
        }
#endif
#ifndef ATT_SKIP_FOX
        if (args.att_sel != 1) for (;;) {
            int job, tr0; NEXT_JOB(2, 1, job, tr0);
            if (job < 256) att::attn_unit<false>(lds, QB, KB, VT + (size_t)1024 * SEQ, C2, OB, nullptr, job & 7, 31 - (job >> 3), 0, 0.f, GN);
            TR_DO(tr0, 1);
            if (job >= 256) break;
        }
#endif
        if (args.att_sel == 0) TR_ROUNDS(1 << 30);
#undef NEXT_JOB
#undef TR_ROUNDS
#undef TR_DO
#undef TR_ITEM
    }
    SEAM(2);

    if (IN(3)) {
        const bf16_t* o0 = (const bf16_t*)out; const bf16_t* o1 = o0 + (size_t)SEQ * 1024;
        f32x4 sg[4];
#pragma unroll
        for (int i = 0; i < 4; ++i) sg[i] = *(const f32x4*)(subln + (lane & 7) * 16 + 4 * i) * 0.8f;
        for (int row = gw; row < SEQ; row += NGW) {
            const size_t off = (size_t)row * 1024 + lane * 16;
            f32x4 v[4]; float ss = 0.f;
#pragma unroll
            for (int i = 0; i < 2; ++i) { const u32x4 a = *(const u32x4*)(o0 + off + 8 * i), b = *(const u32x4*)(o1 + off + 8 * i);
                v[2 * i] = (f32x4){bf_lo(a.x) + bf_lo(b.x), bf_hi(a.x) + bf_hi(b.x), bf_lo(a.y) + bf_lo(b.y), bf_hi(a.y) + bf_hi(b.y)};
                v[2 * i + 1] = (f32x4){bf_lo(a.z) + bf_lo(b.z), bf_hi(a.z) + bf_hi(b.z), bf_lo(a.w) + bf_lo(b.w), bf_hi(a.w) + bf_hi(b.w)}; }
#pragma unroll
            for (int i = 0; i < 4; ++i) ss += (v[i][0] * v[i][0] + v[i][1] * v[i][1]) + (v[i][2] * v[i][2] + v[i][3] * v[i][3]);
            ss += __shfl_xor(ss, 1); ss += __shfl_xor(ss, 2); ss += __shfl_xor(ss, 4);
            const float rinv = fast_rsq(ss * (1.f / 128.f) + EPS);
#pragma unroll
            for (int i = 0; i < 4; ++i) v[i] = v[i] * rinv * sg[i];
            *(u32x4*)(OA + off) = pack8(v[0], v[1]); *(u32x4*)(OA + off + 8) = pack8(v[2], v[3]);
        }
    }


    SEAM(3);

    if (IN(4)) {
        pg8::Gemm g{OA, OB, Wbd, Wbf, 1024};
        pg8::P3Order S{G, bx};
        pg8::EpiP3 E{Gt, MGT, MG};
        pg8::gemm_phase(lds, g, S, E);
    }
    SEAM(4);

    if (IN(5)) {
        pg8::Gemm g{MG, MG, Wout, Wout, DM};
        pg8::PlainOrder S{32, 8, G, bx};
        pg8::EpiP4 E{x, (bf16_t*)(ws + WS_X1B), SS2};
        pg8::gemm_phase(lds, g, S, E);
    }
    SEAM(5);

    if (IN(6)) {
        pg8::Gemm g{(const bf16_t*)(ws + WS_X1B), (const bf16_t*)(ws + WS_X1B), Wup, Wup, DM};
        pg8::PlainOrder S{32, 32, G, bx};
        pg8::Unit u0; int pm0 = -1;
        if (S.next(0, u0)) { pm0 = u0.pm;
            LAS float* tab = (LAS float*)(lds + EPI_SCR_OFF);
            if (tid < 256) { const f32x4* sp = (const f32x4*)(SS2 + (size_t)(pm0 * 256 + tid) * 32); f32x4 sa = sp[0];
#pragma unroll
                for (int q = 1; q < 8; ++q) sa += sp[q];
                tab[tid] = fast_rsq(((sa[0] + sa[1]) + (sa[2] + sa[3])) * (1.f / DM) + EPS); }
            __syncthreads(); }
        pg8::EpiP5 E{SS2, U, pm0};
        pg8::gemm_phase(lds, g, S, E);
    }
    SEAM(6);

    if (IN(7)) {
        pg8::Gemm g{U, U, Wdown, Wdown, FF};
        pg8::PlainOrder S{32, 8, G, bx};
        pg8::EpiP6 E{(const bf16_t*)(ws + WS_X1B), out};
        pg8::gemm_phase(lds, g, S, E);
    }
#undef IN
#undef SEAM
}

#ifdef PROBE_PHASE
__global__ void dump_bf16(const bf16_t* a, const bf16_t* b, float* dst, size_t nhalf) {
    for (size_t i = blockIdx.x * (size_t)blockDim.x + threadIdx.x; i < nhalf; i += (size_t)gridDim.x * blockDim.x) { dst[i] = bf_lo((unsigned)a[i]); dst[nhalf + i] = bf_lo((unsigned)b[i]); }
}
#endif
extern "C" void kernel_launch(void* const* d_in, const int* in_sizes, int n_in, void* d_out, int out_size, void* d_ws, size_t ws_size, hipStream_t stream) {
    static int grid = 0;
    if (grid == 0) {
        if (n_in != 21 || out_size != SEQ * DM || ws_size < WS_END) { fprintf(stderr, "kernel_launch: unexpected problem (n_in %d, out %d, ws %zu)\n", n_in, out_size, ws_size); grid = -1; return; }
        int dev = 0, cus = 0, per_cu = 0;
        hipGetDevice(&dev);
        hipDeviceGetAttribute(&cus, hipDeviceAttributeMultiprocessorCount, dev);
        hipFuncSetAttribute((const void*)fwd_kernel, hipFuncAttributeMaxDynamicSharedMemorySize, LDS_BYTES);
        hipOccupancyMaxActiveBlocksPerMultiprocessor(&per_cu, (const void*)fwd_kernel, NTHREADS, LDS_BYTES);
        if (per_cu < 1) { fprintf(stderr, "kernel_launch: occupancy query says %d blocks per CU\n", per_cu); per_cu = 1; }
        if (per_cu > 1) per_cu = 1;
        grid = cus * per_cu;
        (void)hipGetLastError();
    }
    if (grid < 0) return;
    (void)hipMemsetAsync((char*)d_ws + WS_CTL, 0, CTL_BYTES, stream);
    Args a{};
    for (int i = 0; i < 21; ++i) a.in[i] = (const float*)d_in[i];
    a.out = (float*)d_out; a.ws = (unsigned char*)d_ws;
#if REPEAT_PHASE >= 0
    for (int p = 0; p < 8; ++p) { a.ph_lo = p; a.ph_hi = p + 1; a.att_sel = 0; hipLaunchKernelGGL(fwd_kernel, dim3(grid), dim3(NTHREADS), LDS_BYTES, stream, a);
        if ((REPEAT_PHASE >> p) & 1) { a.att_sel = REPEAT_PHASE >> 8; (void)hipMemsetAsync((char*)d_ws + WS_CTL, 0, 64, stream); hipLaunchKernelGGL(fwd_kernel, dim3(grid), dim3(NTHREADS), LDS_BYTES, stream, a); } }
#elif MK_N_LAUNCHES == 1
    a.ph_lo = 0; a.ph_hi = 8;
    void* kargs[] = {&a};
    hipError_t e = hipLaunchCooperativeKernel((const void*)fwd_kernel, dim3(grid), dim3(NTHREADS), kargs, LDS_BYTES, stream);
    if (e != hipSuccess) fprintf(stderr, "cooperative launch failed: %s (grid %d)\n", hipGetErrorString(e), grid);
#else
#ifdef PROBE_PHASE
    for (int p = 0; p <= PROBE_PHASE; ++p) { a.ph_lo = p; a.ph_hi = p + 1; hipLaunchKernelGGL(fwd_kernel, dim3(grid), dim3(NTHREADS), LDS_BYTES, stream, a); }
    { const unsigned char* w = (const unsigned char*)d_ws; hipLaunchKernelGGL(dump_bf16, dim3(2048), dim3(256), 0, stream, (const bf16_t*)(w + PROBE_A), (const bf16_t*)(w + PROBE_B), (float*)d_out, (size_t)SEQ * 1024); }
#else
    for (int p = 0; p < 8; ++p) { a.ph_lo = p; a.ph_hi = p + 1; hipLaunchKernelGGL(fwd_kernel, dim3(grid), dim3(NTHREADS), LDS_BYTES, stream, a); }
#endif
#endif
}
```

```cpp
#include <hip/hip_runtime.h>
#include <hip/hip_cooperative_groups.h>
#include <cstdio>
#include <cstdint>
namespace cg = cooperative_groups;

#ifndef REPEAT_PHASE
#define REPEAT_PHASE -1
#endif
#ifndef MK_N_LAUNCHES
#define MK_N_LAUNCHES 1
#endif

#define LAS __attribute__((address_space(3)))
typedef unsigned short bf16_t;
typedef short bf16x8 __attribute__((ext_vector_type(8)));
typedef float f32x4 __attribute__((ext_vector_type(4)));
typedef float f32x16 __attribute__((ext_vector_type(16)));
typedef unsigned u32x4 __attribute__((ext_vector_type(4)));
typedef unsigned u32x2 __attribute__((ext_vector_type(2)));

constexpr int SEQ = 8192, DM = 2048, NPROJ = 6152, FF = 8192;
constexpr float EPS = 1e-6f, LOG2E = 1.4426950408889634f;
constexpr int NTHREADS = 512, NWAVES = 8;

constexpr size_t MiB = 1u << 20;
constexpr size_t WS_LF = 0;
constexpr size_t WS_C2 = 256 * 1024;
constexpr size_t WS_GN = 512 * 1024;
constexpr size_t WS_CTL = 768 * 1024;
constexpr size_t CTL_BYTES = 32768;
constexpr size_t WS_SS2 = 1 * MiB;
constexpr size_t WS_WBD = 8 * MiB, WS_WBF = 12 * MiB, WS_WOUT = 16 * MiB;
constexpr size_t WS_WT1 = 24 * MiB, WS_WUP = 24 * MiB;
constexpr size_t WS_WT2 = 56 * MiB;
constexpr size_t WS_H = 64 * MiB, WS_WDOWN = 64 * MiB;
constexpr size_t WS_QA = 96 * MiB, WS_KA = 112 * MiB, WS_QB = 128 * MiB, WS_KB = 144 * MiB;
constexpr size_t WS_MGT = 96 * MiB;
constexpr size_t WS_VT = 160 * MiB, WS_MG = 160 * MiB;
constexpr size_t WS_G = 192 * MiB;
constexpr size_t WS_OA = 256 * MiB, WS_OB = 272 * MiB, WS_XG = 256 * MiB;
constexpr size_t WS_X1B = 224 * MiB;
constexpr size_t WS_U = 96 * MiB;
constexpr size_t WS_END = 288 * MiB;

constexpr int GEMM_LDS = 131072;
constexpr int EPI_SCR_OFF = GEMM_LDS;
constexpr int LDS_BYTES = GEMM_LDS + 4096 + 1024;
constexpr int LDS_BAR_OFF = LDS_BYTES - 16;
constexpr int P0_SCR_STRIDE = 8704, P0_WF_OFF = 8 * P0_SCR_STRIDE;
static_assert(P0_WF_OFF + 65536 <= LDS_BAR_OFF, "P0 LDS map");

typedef float f32x2_t __attribute__((ext_vector_type(2)));
typedef __bf16 bf16x2_t __attribute__((ext_vector_type(2)));
__device__ __forceinline__ unsigned cvt_pk_bf16(float lo, float hi) { const f32x2_t v = {lo, hi}; const bf16x2_t b = __builtin_convertvector(v, bf16x2_t); return __builtin_bit_cast(unsigned, b); }
__device__ __forceinline__ u32x4 pack8(const f32x4& a, const f32x4& b) { u32x4 w; w.x = cvt_pk_bf16(a[0], a[1]); w.y = cvt_pk_bf16(a[2], a[3]); w.z = cvt_pk_bf16(b[0], b[1]); w.w = cvt_pk_bf16(b[2], b[3]); return w; }
__device__ __forceinline__ float bf_lo(unsigned u) { return __uint_as_float(u << 16); }
__device__ __forceinline__ float bf_hi(unsigned u) { return __uint_as_float(u & 0xffff0000u); }
__device__ __forceinline__ float fast_exp2(float x) { return __builtin_amdgcn_exp2f(x); }
__device__ __forceinline__ float fast_rcp(float x) { return __builtin_amdgcn_rcpf(x); }
__device__ __forceinline__ float fast_rsq(float x) { return __builtin_amdgcn_rsqf(x); }
__device__ __forceinline__ float wave_sum(float v) {
#pragma unroll
    for (int o = 1; o < 64; o <<= 1) v += __shfl_xor(v, o);
    return v;
}
#define LDS_WAIT() asm volatile("s_waitcnt lgkmcnt(0)" ::: "memory")

namespace pg8 {
constexpr int BM = 256, BK = 64, HALF = 128, HTB = HALF * BK * 2, STAGE_BYTES = 8 * HTB, NXCD = 8, WGM = 8;
__host__ __device__ __forceinline__ int lds_byte(int r, int c) { const int st = (r >> 4) * 2 + (c >> 5), rr = r & 15, cc = c & 31, ob = rr * 64 + cc * 2; return st * 1024 + (ob ^ (((ob >> 9) & 1) << 5)); }
__host__ __device__ __forceinline__ void stage_rc(int b, int& R, int& C) { const int st = b / 1024, sb = b % 1024, swz = sb ^ (((sb >> 9) & 1) << 5); R = (st >> 1) * 16 + swz / 64; C = (st & 1) * 32 + (swz % 64) / 2; }
__host__ __device__ __forceinline__ int perm32(int rho) { const int n = rho >> 4, i = rho & 15; return 8 * (i >> 2) + 4 * n + (i & 3); }

struct Unit { int pm, pn, sel; };
struct Gemm { const bf16_t *A0, *A1, *B0, *B1; int K; };

__host__ __device__ __forceinline__ void map_tile(int L, int nM, int nN, Unit& u) {
    const int nwg = nM * nN; int wgid = L;
    { const int q = nwg / NXCD, r = nwg % NXCD, xcd = wgid % NXCD, off = wgid / NXCD; wgid = (xcd < r ? xcd * (q + 1) : r * (q + 1) + (xcd - r) * q) + off; }
    const int nig = WGM * nN, gid = wgid / nig, fm = gid * WGM, gsz = (nM - fm) < WGM ? (nM - fm) : WGM;
    u.pm = fm + ((wgid % nig) % gsz); u.pn = (wgid % nig) / gsz;
}
struct PlainOrder { int nM, nN, G, c;
    __device__ __forceinline__ bool next(int i, Unit& u) const { const long L = (long)i * G + c; if (L >= (long)nM * nN) return false; map_tile((int)L, nM, nN, u); u.sel = 0; return true; } };
struct P1Order { int G, c;
    __device__ __forceinline__ bool next(int i, Unit& u) const { long L = (long)i * G + c; if (L < 1024) { map_tile((int)L, 32, 32, u); u.sel = 0; return true; } L -= 1024; if (L < 256) { map_tile((int)L, 8, 32, u); u.sel = 1; return true; } return false; } };
struct P3Order { int G, c;
    __device__ __forceinline__ bool next(int i, Unit& u) const { const long L = (long)(i >> 1) * G + c; if (L >= 256) return false; map_tile((int)L, 32, 8, u); u.sel = i & 1; return true; } };

template <class Epi, class Sched>
__device__ __forceinline__ void gemm_phase(LAS unsigned char* lds, const Gemm g, const Sched& S, const Epi& E) {
    const int tid = threadIdx.x, wid = __builtin_amdgcn_readfirstlane(tid >> 6), lane = tid & 63, wr = wid >> 2, wc = wid & 3, fr = lane & 15, fq = lane >> 4;
    const int K = g.K, nt = K / BK;
    unsigned voffA[2], voffB[2];
#pragma unroll
    for (int i = 0; i < 2; ++i) { int R, C; stage_rc(tid * 16 + i * 8192, R, C); const int Rb = 64 * (R >> 5) + perm32(R & 31);
        voffA[i] = (unsigned)(R * K + C) * 2u; voffB[i] = (unsigned)(Rb * K + C) * 2u; }
    const size_t kstep = (size_t)(BK * 2);
    const size_t hstep = (size_t)HALF * K * 2;
    const size_t hstepB = (size_t)32 * K * 2;
    const size_t tstep = 2 * hstep;
    const unsigned ldsw = (unsigned)wid * 1024u;
    const int aoff = lds_byte(wr * 64 + fr, fq * 8), boff = lds_byte(wc * 32 + fr, fq * 8);
#define PG8_SA(b, h) (((b) * 2 + (h)) * HTB)
#define PG8_SB(b, h) ((4 + (b) * 2 + (h)) * HTB)
#define PG8_STAGE(bufoff, gbase, voff) do { _Pragma("unroll") for (int _i = 0; _i < 2; ++_i) \
        __builtin_amdgcn_global_load_lds((const unsigned*)((const char*)(gbase) + (voff)[_i]), (LAS unsigned*)(lds + (bufoff) + ldsw + _i * 8192), 16, 0, 0); } while (0)
#define PG8_LDA(dst, b, h) do { _Pragma("unroll") for (int m = 0; m < 4; ++m) _Pragma("unroll") for (int k = 0; k < 2; ++k) dst[m][k] = *(const LAS bf16x8*)(lds + PG8_SA(b, h) + aoff + m * 2048 + k * 1024); } while (0)
#define PG8_LDB(dst, b, h) do { _Pragma("unroll") for (int n = 0; n < 2; ++n) _Pragma("unroll") for (int k = 0; k < 2; ++k) dst[n][k] = *(const LAS bf16x8*)(lds + PG8_SB(b, h) + boff + n * 2048 + k * 1024); } while (0)
#define PG8_MMA(ai, bj, At, Bt) do { __builtin_amdgcn_s_setprio(1); _Pragma("unroll") for (int m = 0; m < 4; ++m) _Pragma("unroll") for (int n = 0; n < 2; ++n) _Pragma("unroll") for (int k = 0; k < 2; ++k) \
        acc[ai][bj][m][n] = __builtin_amdgcn_mfma_f32_16x16x32_bf16(Bt[n][k], At[m][k], acc[ai][bj][m][n], 0, 0, 0); __builtin_amdgcn_s_setprio(0); } while (0)
#define PG8_WAIT_V(n) asm volatile("s_waitcnt vmcnt(" #n ")" ::: "memory")
#define PG8_WAIT_L(n) asm volatile("s_waitcnt lgkmcnt(" #n ")" ::: "memory")
#define PG8_BAR __builtin_amdgcn_s_barrier()
#define PG8_SCHED __builtin_amdgcn_sched_barrier(0)
    Unit cur, nxt; int ui = 0;
    if (!S.next(0, cur)) return;
    f32x4 acc[2][2][4][2];
#pragma unroll
    for (int a = 0; a < 2; ++a)
#pragma unroll
        for (int b = 0; b < 2; ++b)
#pragma unroll
            for (int m = 0; m < 4; ++m)
#pragma unroll
                for (int n = 0; n < 2; ++n) acc[a][b][m][n] = (f32x4){0.f, 0.f, 0.f, 0.f};
    bf16x8 At[4][2], B0[2][2], B1[2][2];
    const char* cA = (const char*)(cur.sel ? g.A1 : g.A0) + (size_t)cur.pm * tstep; const char* cB = (const char*)(cur.sel ? g.B1 : g.B0) + (size_t)cur.pn * tstep;
    PG8_STAGE(PG8_SB(0, 0), cB, voffB); PG8_STAGE(PG8_SB(0, 1), cB + hstepB, voffB); PG8_STAGE(PG8_SA(0, 0), cA, voffA); PG8_STAGE(PG8_SA(0, 1), cA + hstep, voffA);
    if (wr == 1) PG8_BAR;
    PG8_WAIT_V(2); PG8_BAR;
    PG8_STAGE(PG8_SB(1, 0), cB + kstep, voffB); PG8_STAGE(PG8_SA(1, 0), cA + kstep, voffA); PG8_STAGE(PG8_SB(1, 1), cB + hstepB + kstep, voffB);
    PG8_WAIT_V(6); PG8_BAR;
    for (;;) {
        const bool has_next = S.next(ui + 1, nxt);
        const char* nA = has_next ? (const char*)(nxt.sel ? g.A1 : g.A0) + (size_t)nxt.pm * tstep : cA; const char* nB = has_next ? (const char*)(nxt.sel ? g.B1 : g.B0) + (size_t)nxt.pn * tstep : cB;
        for (int t = 0; t < nt; t += 2) {
            const bool last = (t == nt - 2);
            const char* a1 = cA + (size_t)(t + 1) * kstep;
            const char* a2 = last ? nA : cA + (size_t)(t + 2) * kstep; const char* b2 = last ? nB : cB + (size_t)(t + 2) * kstep;
            const char* a3 = a2 + kstep; const char* b3 = b2 + kstep;
            PG8_LDB(B0, 0, 0); PG8_LDB(B1, 0, 1); PG8_SCHED; PG8_LDA(At, 0, 0); PG8_STAGE(PG8_SA(1, 1), a1 + hstep, voffA);
            PG8_WAIT_V(8); PG8_WAIT_L(0); PG8_BAR; PG8_MMA(0, 0, At, B0); PG8_MMA(0, 1, At, B1); PG8_BAR; PG8_SCHED;
            PG8_LDA(At, 0, 1); PG8_STAGE(PG8_SB(0, 0), b2, voffB); PG8_STAGE(PG8_SB(0, 1), b2 + hstepB, voffB); PG8_STAGE(PG8_SA(0, 0), a2, voffA);
            PG8_WAIT_V(8); PG8_WAIT_L(0); PG8_BAR; PG8_MMA(1, 0, At, B0); PG8_MMA(1, 1, At, B1); PG8_BAR; PG8_SCHED;
            PG8_LDB(B0, 1, 0); PG8_LDB(B1, 1, 1); PG8_SCHED; PG8_LDA(At, 1, 0); PG8_STAGE(PG8_SA(0, 1), a2 + hstep, voffA);
            PG8_WAIT_V(8); PG8_WAIT_L(0); PG8_BAR; PG8_MMA(0, 0, At, B0); PG8_MMA(0, 1, At, B1); PG8_BAR; PG8_SCHED;
            PG8_LDA(At, 1, 1); PG8_STAGE(PG8_SB(1, 0), b3, voffB); PG8_STAGE(PG8_SB(1, 1), b3 + hstepB, voffB); PG8_STAGE(PG8_SA(1, 0), a3, voffA);
            PG8_WAIT_V(8); PG8_WAIT_L(0); PG8_BAR; PG8_MMA(1, 0, At, B0); PG8_MMA(1, 1, At, B1); PG8_BAR; PG8_SCHED;
        }
        if (wr == 0) PG8_BAR;
        E(acc, cur, wr, wc, fr, fq, (LAS float*)(lds + EPI_SCR_OFF));
        if (!has_next) break;
#pragma unroll
        for (int a = 0; a < 2; ++a)
#pragma unroll
            for (int b = 0; b < 2; ++b)
#pragma unroll
                for (int m = 0; m < 4; ++m)
#pragma unroll
                    for (int n = 0; n < 2; ++n) acc[a][b][m][n] = (f32x4){0.f, 0.f, 0.f, 0.f};
        cur = nxt; cA = nA; cB = nB; ++ui;
        if (wr == 1) PG8_BAR;
    }
    PG8_WAIT_V(0);
    PG8_BAR;
#undef PG8_SA
#undef PG8_SB
#undef PG8_STAGE
#undef PG8_LDA
#undef PG8_LDB
#undef PG8_MMA
#undef PG8_WAIT_V
#undef PG8_WAIT_L
#undef PG8_BAR
#undef PG8_SCHED
}

typedef f32x4 Acc[2][2][4][2];

struct EpiP1 {
    bf16_t *QA, *G, *VT; const float *GN, *bgate;
    __device__ __forceinline__ void operator()(Acc& acc, const Unit& u, int wr, int wc, int fr, int fq, LAS float* scr) const {
        const int colw = 64 * wc + 8 * fq, rowl = wr * 64 + fr;
        if (u.sel == 1) {
            const int tok0 = u.pn * BM + colw;
#pragma unroll
            for (int ai = 0; ai < 2; ++ai)
#pragma unroll
                for (int m = 0; m < 4; ++m) { const int vd = u.pm * BM + rowl + ai * HALF + m * 16;
#pragma unroll
                    for (int bj = 0; bj < 2; ++bj) { const int tok = tok0 + 32 * bj;
                        *(u32x4*)(VT + ((size_t)((vd >> 7) * 128 + (tok >> 6)) * 8192 + (vd & 127) * 64 + (tok & 63))) = pack8(acc[ai][bj][m][0], acc[ai][bj][m][1]); } }
            return;
        }
        if (u.pn >= 16) {
            const int gcol = (u.pn - 16) * BM + colw;
            f32x4 bv[2][2];
#pragma unroll
            for (int bj = 0; bj < 2; ++bj)
#pragma unroll
                for (int n = 0; n < 2; ++n) bv[bj][n] = *(const f32x4*)(bgate + gcol + 32 * bj + 4 * n);
            bf16_t* base = G + (size_t)(u.pm * BM + rowl) * 4096 + gcol;
#pragma unroll
            for (int ai = 0; ai < 2; ++ai)
#pragma unroll
                for (int m = 0; m < 4; ++m) { bf16_t* rp = base + (size_t)(ai * HALF + m * 16) * 4096;
#pragma unroll
                    for (int bj = 0; bj < 2; ++bj) { f32x4 v[2];
#pragma unroll
                        for (int n = 0; n < 2; ++n)
#pragma unroll
                            for (int j = 0; j < 4; ++j) { const float z = acc[ai][bj][m][n][j] + bv[bj][n][j]; v[n][j] = fast_rcp(1.f + fast_exp2(-z * LOG2E)); }
                        *(u32x4*)(rp + 32 * bj) = pack8(v[0], v[1]); } }
            return;
        }
        const int t = u.pn >> 2; const bool fox = t >= 2;
        bf16_t* O = QA + (size_t)t * (8u << 20);
        const float* gn = GN + t * 128;
        const int d0 = (fox ? 64 * (wc & 1) : 0) + 8 * fq;
        f32x4 gv[2][2];
#pragma unroll
        for (int bj = 0; bj < 2; ++bj)
#pragma unroll
            for (int n = 0; n < 2; ++n) gv[bj][n] = *(const f32x4*)(gn + d0 + 32 * bj + 4 * n);
        float ss[2][4];
#pragma unroll
        for (int ai = 0; ai < 2; ++ai)
#pragma unroll
            for (int m = 0; m < 4; ++m) { float s = 0.f;
#pragma unroll
                for (int bj = 0; bj < 2; ++bj)
#pragma unroll
                    for (int n = 0; n < 2; ++n) { const f32x4 x = acc[ai][bj][m][n]; s += (x[0] * x[0] + x[1] * x[1]) + (x[2] * x[2] + x[3] * x[3]); }
                s += __shfl_xor(s, 16); s += __shfl_xor(s, 32); ss[ai][m] = s; }
        if (fox) {
            if (fq == 0) {
#pragma unroll
                for (int ai = 0; ai < 2; ++ai)
#pragma unroll
                    for (int m = 0; m < 4; ++m) scr[(ai * HALF + rowl + m * 16) * 4 + wc] = ss[ai][m];
            }
            LDS_WAIT(); __builtin_amdgcn_s_barrier(); asm volatile("" ::: "memory");
#pragma unroll
            for (int ai = 0; ai < 2; ++ai)
#pragma unroll
                for (int m = 0; m < 4; ++m) ss[ai][m] += scr[(ai * HALF + rowl + m * 16) * 4 + (wc ^ 1)];
            LDS_WAIT();
        }
        const float inv = fox ? (1.f / 128.f) : (1.f / 64.f);
        const bool isk = (t & 1) != 0; const int wsh = fox ? 7 : 6;
#pragma unroll
        for (int ai = 0; ai < 2; ++ai)
#pragma unroll
            for (int m = 0; m < 4; ++m) { const float rinv = fast_rsq(ss[ai][m] * inv + EPS); const int tok = u.pm * BM + rowl + ai * HALF + m * 16;
#pragma unroll
                for (int bj = 0; bj < 2; ++bj) { const f32x4 v0 = acc[ai][bj][m][0] * rinv * gv[bj][0], v1 = acc[ai][bj][m][1] * rinv * gv[bj][1];
                    const int col = (u.pn & 3) * BM + colw + 32 * bj;
                    const size_t off = isk ? ((size_t)((col >> wsh) * 128 + (tok >> 6)) << (6 + wsh)) + ((tok & 63) << wsh) + (col & ((1 << wsh) - 1)) : (size_t)tok * 1024 + col;
                    *(u32x4*)(O + off) = pack8(v0, v1); } }
    }
};

struct EpiP3 {
    const bf16_t* G; bf16_t* MGT; bf16_t* MG;
    __device__ __forceinline__ void operator()(Acc& acc, const Unit& u, int wr, int wc, int fr, int fq, LAS float*) const {
        const int col = u.pn * BM + 64 * wc + 8 * fq, row0 = u.pm * BM + wr * 64 + fr;
#pragma unroll
        for (int ai = 0; ai < 2; ++ai)
#pragma unroll
            for (int m = 0; m < 4; ++m) { const size_t row = (size_t)(row0 + ai * HALF + m * 16);
#pragma unroll
                for (int bj = 0; bj < 2; ++bj) { const int c = col + 32 * bj;
                    const u32x4 gw = *(const u32x4*)(G + row * 4096 + (u.sel ? 2048 : 0) + c);
                    const f32x4 g0 = {bf_lo(gw.x), bf_hi(gw.x), bf_lo(gw.y), bf_hi(gw.y)}, g1 = {bf_lo(gw.z), bf_hi(gw.z), bf_lo(gw.w), bf_hi(gw.w)};
                    f32x4 v0 = acc[ai][bj][m][0] * g0, v1 = acc[ai][bj][m][1] * g1;
                    bf16_t* tp = MGT + row * DM + c;
                    if (u.sel == 0) { *(u32x4*)tp = pack8(v0, v1); }
                    else { const u32x4 tw = *(const u32x4*)tp;
                        v0 += (f32x4){bf_lo(tw.x), bf_hi(tw.x), bf_lo(tw.y), bf_hi(tw.y)}; v1 += (f32x4){bf_lo(tw.z), bf_hi(tw.z), bf_lo(tw.w), bf_hi(tw.w)};
                        *(u32x4*)(MG + row * DM + c) = pack8(v0, v1); } } }
    }
};

struct EpiP4 {
    const float* x; bf16_t* X1B; float* SS2;
    __device__ __forceinline__ void operator()(Acc& acc, const Unit& u, int wr, int wc, int fr, int fq, LAS float*) const {
        const int col = u.pn * BM + 64 * wc + 8 * fq, row0 = u.pm * BM + wr * 64 + fr;
#pragma unroll
        for (int ai = 0; ai < 2; ++ai)
#pragma unroll
            for (int m = 0; m < 4; ++m) { const size_t row = (size_t)(row0 + ai * HALF + m * 16); float s = 0.f;
#pragma unroll
                for (int bj = 0; bj < 2; ++bj) { const size_t o = row * DM + col + 32 * bj;
                    const f32x4 v0 = acc[ai][bj][m][0] + *(const f32x4*)(x + o), v1 = acc[ai][bj][m][1] + *(const f32x4*)(x + o + 4);
                    *(u32x4*)(X1B + o) = pack8(v0, v1);
                    s += (v0[0] * v0[0] + v0[1] * v0[1]) + (v0[2] * v0[2] + v0[3] * v0[3]) + (v1[0] * v1[0] + v1[1] * v1[1]) + (v1[2] * v1[2] + v1[3] * v1[3]); }
                s += __shfl_xor(s, 16); s += __shfl_xor(s, 32);
                if (fq == 0) SS2[row * 32 + u.pn * 4 + wc] = s; }
    }
};

struct EpiP5 {
    const float* SS2; bf16_t* U; int pm0;
    __device__ __forceinline__ void operator()(Acc& acc, const Unit& u, int wr, int wc, int fr, int fq, LAS float* scr) const {
        const int col = u.pn * BM + 64 * wc + 8 * fq, row0 = u.pm * BM + wr * 64 + fr;
#pragma unroll
        for (int ai = 0; ai < 2; ++ai)
#pragma unroll
            for (int m = 0; m < 4; ++m) { const size_t row = (size_t)(row0 + ai * HALF + m * 16);
                float rinv;
                if (u.pm == pm0) rinv = scr[wr * 64 + fr + ai * HALF + m * 16];
                else { const f32x4* sp = (const f32x4*)(SS2 + row * 32); f32x4 sa = sp[0];
#pragma unroll
                    for (int q = 1; q < 8; ++q) sa += sp[q];
                    rinv = fast_rsq(((sa[0] + sa[1]) + (sa[2] + sa[3])) * (1.f / DM) + EPS); }
#pragma unroll
                for (int bj = 0; bj < 2; ++bj) { f32x4 v[2];
#pragma unroll
                    for (int n = 0; n < 2; ++n)
#pragma unroll
                        for (int j = 0; j < 4; ++j) { const float z = fmaxf(acc[ai][bj][m][n][j] * rinv, 0.f); v[n][j] = z * z; }
                    *(u32x4*)(U + row * FF + col + 32 * bj) = pack8(v[0], v[1]); } }
    }
};

struct EpiP6 {
    const bf16_t* X1B; float* out;
    __device__ __forceinline__ void operator()(Acc& acc, const Unit& u, int wr, int wc, int fr, int fq, LAS float*) const {
        const int col = u.pn * BM + 64 * wc + 8 * fq, row0 = u.pm * BM + wr * 64 + fr;
#pragma unroll
        for (int ai = 0; ai < 2; ++ai)
#pragma unroll
            for (int m = 0; m < 4; ++m) { const size_t row = (size_t)(row0 + ai * HALF + m * 16);
#pragma unroll
                for (int bj = 0; bj < 2; ++bj) { const size_t o = row * DM + col + 32 * bj; const u32x4 xw = *(const u32x4*)(X1B + o);
                    const f32x4 v0 = acc[ai][bj][m][0] + (f32x4){bf_lo(xw.x), bf_hi(xw.x), bf_lo(xw.y), bf_hi(xw.y)}, v1 = acc[ai][bj][m][1] + (f32x4){bf_lo(xw.z), bf_hi(xw.z), bf_lo(xw.w), bf_hi(xw.w)};
                    *(f32x4*)(out + o) = v0; *(f32x4*)(out + o + 4) = v1; } }
    }
};
}

__device__ __forceinline__ void transpose_item(const float* __restrict__ W, int ld, int col0, int ncols, int K, bf16_t* WT, int row_off, LAS float* scr, int item, int lane) {
    const int nblk = ncols / 32, kb = item / nblk, nb = item % nblk, k0 = 64 * kb, n0 = 32 * nb;
    const float* wp = W + (size_t)(k0 + (lane >> 5)) * ld + col0 + n0 + (lane & 31);
    LAS float* sp = scr + (lane >> 5) * 33 + (lane & 31);
#pragma unroll 4
    for (int i = 0; i < 32; ++i) { sp[i * 66] = *wp; wp += 2 * ld; }
    LDS_WAIT();
    const int c = lane & 7;
#pragma unroll
    for (int j = 0; j < 4; ++j) { const int n = (lane >> 3) + 8 * j; const LAS float* s = scr + (8 * c) * 33 + n;
        u32x4 o; o.x = cvt_pk_bf16(s[0 * 33], s[1 * 33]); o.y = cvt_pk_bf16(s[2 * 33], s[3 * 33]); o.z = cvt_pk_bf16(s[4 * 33], s[5 * 33]); o.w = cvt_pk_bf16(s[6 * 33], s[7 * 33]);
        *(u32x4*)(WT + (size_t)(row_off + n0 + n) * K + k0 + 8 * c) = o; }
    LDS_WAIT();
}

__device__ __forceinline__ void transpose_item64(const float* __restrict__ W, int ld, int ncols, int K, bf16_t* WT, LAS float* scr, int item, int lane, const float* ks = nullptr) {
    const int nblk = ncols / 64, kb = item / nblk, nb = item % nblk, k0 = 64 * kb, n0 = 64 * nb;
    const float* wp = W + (size_t)(k0 + (lane >> 4)) * ld + n0 + 4 * (lane & 15);
    f32x4 v[16];
#pragma unroll
    for (int i = 0; i < 16; ++i) v[i] = *(const f32x4*)(wp + (size_t)(4 * i) * ld);
    if (ks) {
#pragma unroll
        for (int i = 0; i < 16; ++i) v[i] = v[i] * ks[k0 + 4 * i + (lane >> 4)]; }
    LAS float* sp = scr + (lane >> 4) * 65 + 4 * (lane & 15);
#pragma unroll
    for (int i = 0; i < 16; ++i) { sp[(4 * i) * 65 + 0] = v[i][0]; sp[(4 * i) * 65 + 1] = v[i][1]; sp[(4 * i) * 65 + 2] = v[i][2]; sp[(4 * i) * 65 + 3] = v[i][3]; }
    LDS_WAIT();
    const int c = lane >> 3;
#pragma unroll
    for (int j = 0; j < 8; ++j) { const int n = (lane & 7) + 8 * j; const LAS float* s = scr + (8 * c) * 65 + n;
        u32x4 o; o.x = cvt_pk_bf16(s[0 * 65], s[1 * 65]); o.y = cvt_pk_bf16(s[2 * 65], s[3 * 65]); o.z = cvt_pk_bf16(s[4 * 65], s[5 * 65]); o.w = cvt_pk_bf16(s[6 * 65], s[7 * 65]);
        *(u32x4*)(WT + (size_t)(n0 + n) * K + k0 + 8 * c) = o; }
    LDS_WAIT();
}

namespace att {
constexpr int VROW = 144, BUF = 36864;
static_assert(2 * BUF <= GEMM_LDS, "attention LDS map");
#define MFMA32(a, b, c) __builtin_amdgcn_mfma_f32_32x32x16_bf16((a), (b), (c), 0, 0, 0)

__device__ __forceinline__ void pack_p(const f32x16& S, bf16x8 (&pf)[2]) {
#pragma unroll
    for (int s = 0; s < 2; ++s) { u32x4 p; p.x = cvt_pk_bf16(S[8 * s + 0], S[8 * s + 1]); p.y = cvt_pk_bf16(S[8 * s + 2], S[8 * s + 3]); p.z = cvt_pk_bf16(S[8 * s + 4], S[8 * s + 5]); p.w = cvt_pk_bf16(S[8 * s + 6], S[8 * s + 7]);
        pf[s] = __builtin_bit_cast(bf16x8, p); }
}
constexpr float PRUNE_THR = 80.f;
template <bool DIFF>
__device__ __forceinline__ void attn_unit(LAS unsigned char* lds, const bf16_t* __restrict__ Q, const bf16_t* __restrict__ Kg, const bf16_t* __restrict__ Vt, const float* __restrict__ c2g,
                                          bf16_t* Og, float* Of, int head, int qb, int mp, float lam, const float* GN) {
    constexpr int NX = DIFF ? 4 : 8, KROW = DIFF ? 144 : 272, V_OFF = 64 * KROW, C2_OFF = V_OFF + 128 * VROW;
    static_assert(C2_OFF + 256 <= BUF, "attention buffer");
    const int tid = threadIdx.x, lane = tid & 63, w = __builtin_amdgcn_readfirstlane(tid >> 6), r = lane & 31, h = lane >> 5;
    const int trow = qb * 256 + 32 * w + r;
    const int jmax = 4 * qb + 3, jd = 4 * qb + (w >> 1);
    const int toff = 32 * (w & 1) + r;
    const float slope2 = DIFF ? exp2f(-(float)(head + 1)) * LOG2E : 0.f;
    const bf16_t* gV = Vt + (size_t)head * 128 * 8192 + tid * 8;
    const unsigned lV = V_OFF + (tid >> 3) * VROW + (tid & 7) * 16;
    const unsigned lK = DIFF ? (tid >> 3) * KROW + (tid & 7) * 16 : (tid >> 4) * KROW + (tid & 15) * 16;
    const int kap = (r & ~12) | ((r & 4) << 1) | ((r & 8) >> 1);
    const unsigned rK = kap * KROW + 16 * h, rV = V_OFF + r * VROW + 16 * h;
    f32x16 O[4];
    int jmin = 0;
    if (DIFF) {
        float gq = fabsf(GN[lane]), gk = fabsf(GN[128 + lane]);
#pragma unroll
        for (int o = 1; o < 64; o <<= 1) { gq = fmaxf(gq, __shfl_xor(gq, o)); gk = fmaxf(gk, __shfl_xor(gk, o)); }
        const float B2 = 2.f * 1.05f * 64.f * gq * gk;
        const float dmax = (PRUNE_THR + B2) / slope2;
        const float jf = ceilf(((float)(256 * qb - 63) - dmax) * (1.f / 64.f));
        jmin = jf > 0.f ? (int)jf : 0;
    } else {
        float gq = fmaxf(fabsf(GN[256 + lane]), fabsf(GN[320 + lane])), gk = fmaxf(fabsf(GN[384 + lane]), fabsf(GN[448 + lane]));
#pragma unroll
        for (int o = 1; o < 64; o <<= 1) { gq = fmaxf(gq, __shfl_xor(gq, o)); gk = fmaxf(gk, __shfl_xor(gk, o)); }
        const float B2 = 2.f * 1.05f * 128.f * gq * gk;
        const float cref = c2g[head * SEQ + 256 * qb];
        const int j0 = lane, j1 = lane + 64;
        const bool n0 = (j0 <= jmax) && (B2 + c2g[head * SEQ + 64 * (j0 <= jmax ? j0 : 0) + 63] - cref >= -PRUNE_THR);
        const bool n1 = (j1 <= jmax) && (B2 + c2g[head * SEQ + 64 * (j1 <= jmax ? j1 : 0) + 63] - cref >= -PRUNE_THR);
        const unsigned long long b0 = __ballot(n0), b1 = __ballot(n1);
        jmin = b0 ? (__ffsll((long long)b0) - 1) : (b1 ? 64 + __ffsll((long long)b1) - 1 : 4 * qb);
        if (jmin > 4 * qb) jmin = 4 * qb;
    }
    jmin = __builtin_amdgcn_readfirstlane(jmin);
    {
        bf16x8 qf[NX];
        { const bf16_t* qp = Q + (size_t)trow * 1024 + head * 128 + (DIFF ? 64 * mp : 0) + 8 * h;
#pragma unroll
          for (int x = 0; x < NX; ++x) qf[x] = *(const bf16x8*)(qp + 16 * x);
#pragma unroll
          for (int x = 0; x < NX; ++x) asm volatile("" : "+v"(qf[x])); }
        const bf16_t* gK = DIFF ? Kg + (size_t)(head * 2 + mp) * 128 * 4096 + tid * 8 : Kg + (size_t)head * 128 * 8192 + tid * 8;
        u32x4 kreg[2], vreg[2]; float creg = 0.f;
#define ATT_LOAD(j) do { const size_t j_ = (size_t)(j); kreg[0] = *(const u32x4*)(gK + j_ * (DIFF ? 4096 : 8192)); if (!DIFF) kreg[1] = *(const u32x4*)(gK + j_ * 8192 + 4096); \
        vreg[0] = *(const u32x4*)(gV + j_ * 8192); vreg[1] = *(const u32x4*)(gV + j_ * 8192 + 4096); if (!DIFF && tid < 64) creg = c2g[head * SEQ + j_ * 64 + tid]; } while (0)
#define ATT_WRITE(b) do { LAS unsigned char* bp_ = lds + (b) * BUF; *(LAS u32x4*)(bp_ + lK) = kreg[0]; if (!DIFF) *(LAS u32x4*)(bp_ + lK + 32 * KROW) = kreg[1]; \
        *(LAS u32x4*)(bp_ + lV) = vreg[0]; *(LAS u32x4*)(bp_ + lV + 64 * VROW) = vreg[1]; if (!DIFF && tid < 64) *(LAS float*)(bp_ + C2_OFF + tid * 4) = creg; } while (0)
#pragma unroll
        for (int db = 0; db < 4; ++db)
#pragma unroll
            for (int i = 0; i < 16; ++i) O[db][i] = 0.f;
        float m = DIFF ? slope2 * (float)toff : c2g[head * SEQ + trow], l = 0.f;
        asm volatile("" : "+v"(m));
        ATT_LOAD(jmax); ATT_WRITE(0);
        __syncthreads();
        int cur = 0;
        for (int j = jmax; j >= jmin; --j) {
            if (j > jd) { if (j > jmin) ATT_LOAD(j - 1); }
            if (j <= jd) {
                const bool diag = (j == jd);
                const LAS unsigned char* bp = lds + cur * BUF;
                if (__any(l > 1.8446744e19f)) {
                    const float a = 5.421010862e-20f; l *= a; m += 64.f;
#pragma unroll
                    for (int db = 0; db < 4; ++db) O[db] *= a;
                }
                if (DIFF && !diag) m += 64.f * slope2;
                f32x16 S0, S1;
                bf16x8 kfa[NX], kfb[DIFF ? NX : 1];
#pragma unroll
                for (int x = 0; x < NX; ++x) { kfa[x] = *(const LAS bf16x8*)(bp + rK + x * 32); if (DIFF) kfb[x] = *(const LAS bf16x8*)(bp + rK + 32 * KROW + x * 32); }
                asm volatile("" ::: "memory");
                if (DIFF) {
                    if (diag) { int toff_v = toff, h_v = 8 * h; asm volatile("" : "+v"(toff_v), "+v"(h_v)); const float tf = (float)toff_v, hf = (float)h_v, base = slope2 * tf - m;
#pragma unroll
                        for (int i = 0; i < 16; ++i) { const float ko = (float)(16 * (i >> 3) + (i & 7)) + hf; S0[i] = base - slope2 * fabsf(ko - tf); S1[i] = base - slope2 * fabsf(ko + 32.f - tf); } }
                    else { const float base = slope2 * (float)(8 * h) - m;
#pragma unroll
                        for (int i = 0; i < 16; ++i) { S0[i] = fmaf(slope2, (float)(16 * (i >> 3) + (i & 7)), base); S1[i] = fmaf(slope2, (float)(32 + 16 * (i >> 3) + (i & 7)), base); } }
                } else {
                    const LAS f32x4* cp = (const LAS f32x4*)(bp + C2_OFF + (8 * h) * 4);
                    const f32x4 c0 = cp[0], c1 = cp[1], c2v = cp[4], c3 = cp[5], d0 = cp[8], d1 = cp[9], d2 = cp[12], d3 = cp[13];
#pragma unroll
                    for (int i = 0; i < 4; ++i) { S0[i] = c0[i] - m; S0[4 + i] = c1[i] - m; S0[8 + i] = c2v[i] - m; S0[12 + i] = c3[i] - m;
                                                  S1[i] = d0[i] - m; S1[4 + i] = d1[i] - m; S1[8 + i] = d2[i] - m; S1[12 + i] = d3[i] - m; }
                }
                __builtin_amdgcn_s_setprio(2);
                if (DIFF) {
#pragma unroll
                    for (int x = 0; x < NX; ++x) { S0 = MFMA32(kfa[x], qf[x], S0); S1 = MFMA32(kfb[x], qf[x], S1); }
                } else {
#pragma unroll
                    for (int x = 0; x < NX; ++x) S0 = MFMA32(kfa[x], qf[x], S0);
#pragma unroll
                    for (int x = 0; x < NX; ++x) kfa[x] = *(const LAS bf16x8*)(bp + rK + 32 * KROW + x * 32);
                    asm volatile("" ::: "memory");
#pragma unroll
                    for (int x = 0; x < NX; ++x) S1 = MFMA32(kfa[x], qf[x], S1);
                }
                if (j > jmin) ATT_LOAD(j - 1);
                bf16x8 vf0[8], vf1[8];
#pragma unroll
                for (int s = 0; s < 2; ++s)
#pragma unroll
                    for (int db = 0; db < 4; ++db) vf0[s * 4 + db] = *(const LAS bf16x8*)(bp + rV + db * 32 * VROW + s * 32);
                asm volatile("" ::: "memory");
                if (diag) {
                    if (!DIFF) { int toff_v = toff - 8 * h; asm volatile("" : "+v"(toff_v));
#pragma unroll
                        for (int i = 0; i < 16; ++i) { const int ko = 16 * (i >> 3) + (i & 7); if (ko > toff_v) S0[i] = -INFINITY; if (ko + 32 > toff_v) S1[i] = -INFINITY; } }
                    float tm = S0[0];
#pragma unroll
                    for (int i = 1; i < 16; ++i) tm = fmaxf(tm, S0[i]);
#pragma unroll
                    for (int i = 0; i < 16; ++i) tm = fmaxf(tm, S1[i]);
                    tm = fmaxf(tm, __shfl_xor(tm, 32));
                    m += tm;
#pragma unroll
                    for (int i = 0; i < 16; ++i) { S0[i] -= tm; S1[i] -= tm; }
                }
                bf16x8 pf0[2], pf1[2];
                float ls = 0.f;
#pragma unroll
                for (int i = 0; i < 16; ++i) { S0[i] = fast_exp2(S0[i]); ls += S0[i]; }
                pack_p(S0, pf0);
#pragma unroll
                for (int s = 0; s < 2; ++s)
#pragma unroll
                    for (int db = 0; db < 4; ++db) O[db] = MFMA32(vf0[s * 4 + db], pf0[s], O[db]);
#pragma unroll
                for (int s = 0; s < 2; ++s)
#pragma unroll
                    for (int db = 0; db < 4; ++db) vf1[s * 4 + db] = *(const LAS bf16x8*)(bp + rV + db * 32 * VROW + 64 + s * 32);
                asm volatile("" ::: "memory");
#pragma unroll
                for (int i = 0; i < 16; ++i) { S1[i] = fast_exp2(S1[i]); ls += S1[i]; }
                pack_p(S1, pf1);
                l += ls;
#pragma unroll
                for (int s = 0; s < 2; ++s)
#pragma unroll
                    for (int db = 0; db < 4; ++db) O[db] = MFMA32(vf1[s * 4 + db], pf1[s], O[db]);
                __builtin_amdgcn_s_setprio(0);
            }
            if (j > jmin) ATT_WRITE(cur ^ 1);
            __syncthreads();
            cur ^= 1;
        }
        l += __shfl_xor(l, 32);
        const float il = (DIFF && mp == 1) ? -lam / l : 1.f / l;
#pragma unroll
        for (int db = 0; db < 4; ++db) O[db] *= il;
#undef ATT_LOAD
#undef ATT_WRITE
    }
    asm volatile("" ::: "memory");
    bf16_t* op = Og + (DIFF ? (size_t)mp * ((size_t)SEQ * 1024) : (size_t)0) + (size_t)trow * 1024 + head * 128 + 4 * h;
#pragma unroll
    for (int db = 0; db < 4; ++db)
#pragma unroll
        for (int g = 0; g < 4; ++g) { u32x2 o; o.x = cvt_pk_bf16(O[db][4 * g], O[db][4 * g + 1]); o.y = cvt_pk_bf16(O[db][4 * g + 2], O[db][4 * g + 3]);
            *(u32x2*)(op + 32 * db + 8 * g) = o; }
}
}

#define XB_TMO      128
#define XB_XCNT(j)  (256  + 64 * (j))
#define XB_XSUB(j)  (1280 + 64 * (j))
#define XB_XGEN(j)  (2304 + 64 * (j))
#define XB_TOP      3328
#define XB_TOPGEN   3392
#define XCD_BAR_WORDS 3456
#define XB_SPIN_CAP (1u << 22)
__device__ __forceinline__ unsigned xb_ld(unsigned* p)              { return __hip_atomic_load(p, __ATOMIC_RELAXED, __HIP_MEMORY_SCOPE_AGENT); }
__device__ __forceinline__ unsigned xb_add(unsigned* p, unsigned v) { return __hip_atomic_fetch_add(p, v, __ATOMIC_RELAXED, __HIP_MEMORY_SCOPE_AGENT); }
__device__ __forceinline__ unsigned xb_xcc_id() { return (unsigned)__builtin_amdgcn_s_getreg((3 << 11) | 20) & 0xFu; }
#define XB_SPIN(cond, bar) do { unsigned _sp = 0; while (cond) { __builtin_amdgcn_s_sleep(1); \
    if ((++_sp & 255u) == 0u) { if (xb_ld(&(bar)[XB_TMO])) break; if (_sp > XB_SPIN_CAP) { atomicAdd(&(bar)[XB_TMO], 1u); break; } } } } while (0)
struct XcdBarrier { unsigned* bar; unsigned x; volatile LAS unsigned* st; };
__device__ __forceinline__ XcdBarrier xcd_barrier_post(unsigned* bar, volatile LAS unsigned* st) {
    XcdBarrier b; b.bar = bar; b.x = xb_xcc_id(); b.st = st;
    if (threadIdx.x == 0) (void)xb_add(&bar[XB_XCNT(b.x)], 1u);
    return b;
}
__device__ __forceinline__ void xcd_barrier_complete(unsigned* bar, unsigned x, unsigned& nloc, unsigned& nx) {
    const unsigned G = gridDim.x * gridDim.y * gridDim.z;
    unsigned sum, cnt, mine, sp = 0u;
    for (;;) {
        sum = 0u; cnt = 0u; mine = 0u;
#pragma unroll
        for (unsigned j = 0; j < 16; ++j) { const unsigned c = xb_ld(&bar[XB_XCNT(j)]); sum += c; cnt += (c > 0u) ? 1u : 0u; mine = (j == x) ? c : mine; }
        if (sum == G) break;
        __builtin_amdgcn_s_sleep(1);
        if ((++sp & 255u) == 0u) { if (xb_ld(&bar[XB_TMO])) break; if (sp > XB_SPIN_CAP) { atomicAdd(&bar[XB_TMO], 1u); break; } }
    }
    nloc = mine > 0u ? mine : 1u; nx = cnt > 0u ? cnt : 1u;
}
__device__ __forceinline__ void xcd_barrier(const XcdBarrier& b) {
    asm volatile("s_waitcnt vmcnt(0)" ::: "memory");
    __syncthreads();
    if (threadIdx.x == 0) {
        unsigned* bar = b.bar;
        __builtin_amdgcn_s_waitcnt(0);
        unsigned nloc = b.st[0], nx = b.st[1];
        if (nloc == 0u) { xcd_barrier_complete(bar, b.x, nloc, nx); b.st[0] = nloc; b.st[1] = nx; }
        const unsigned k = b.st[2]; b.st[2] = k + 1u;
        const unsigned old = xb_add(&bar[XB_XSUB(b.x)], 1u);
        const unsigned gen = old / nloc;
        if (old + 1u == (gen + 1u) * nloc) {
            __builtin_amdgcn_fence(__ATOMIC_RELEASE, "agent");
            asm volatile("s_waitcnt vmcnt(0)" ::: "memory");
            const unsigned og = xb_add(&bar[XB_TOP], 1u);
            const unsigned tg = og / nx;
            if (og + 1u == (tg + 1u) * nx) xb_add(&bar[XB_TOPGEN], 1u);
        }
        XB_SPIN(xb_ld(&bar[XB_TOPGEN]) == k, bar);
        __builtin_amdgcn_fence(__ATOMIC_ACQUIRE, "agent");
        asm volatile("s_waitcnt vmcnt(0)" ::: "memory");
    }
    __syncthreads();
}

struct Args { const float* in[21]; float* out; unsigned char* ws; int ph_lo, ph_hi, att_sel, pad; };

__global__ void __launch_bounds__(NTHREADS, 2) fwd_kernel(Args args) {
    extern __shared__ __attribute__((aligned(16))) unsigned char lds_raw[];
    LAS unsigned char* lds = (LAS unsigned char*)lds_raw;
    const int tid = threadIdx.x, lane = tid & 63, wave = __builtin_amdgcn_readfirstlane(tid >> 6);
    const int G = gridDim.x, bx = blockIdx.x;
    const int vcu = (G % 8 == 0) ? (bx % 8) * (G / 8) + bx / 8 : bx;
    unsigned char* ws = args.ws;
    const float* x = args.in[0];       const float* norm_mix = args.in[1]; const float* w_in = args.in[2];   const float* b_forget = args.in[3];
    const float* qn_diff = args.in[4]; const float* kn_diff = args.in[5];  const float* lq1 = args.in[6];    const float* lk1 = args.in[7];
    const float* lq2 = args.in[8];     const float* lk2 = args.in[9];      const float* subln = args.in[10]; const float* qn_fox = args.in[11];
    const float* kn_fox = args.in[12]; const float* w_bd = args.in[13];    const float* w_bf = args.in[14];  const float* w_gate = args.in[15];
    const float* b_gate = args.in[16]; const float* w_out = args.in[17];   const float* norm_mlp = args.in[18]; const float* w_up = args.in[19];
    const float* w_down = args.in[20];
    float* out = args.out;
    float* LF = (float*)(ws + WS_LF); float* C2 = (float*)(ws + WS_C2); float* SS2 = (float*)(ws + WS_SS2); float* GN = (float*)(ws + WS_GN);
    bf16_t *Wbd = (bf16_t*)(ws + WS_WBD), *Wbf = (bf16_t*)(ws + WS_WBF), *Wout = (bf16_t*)(ws + WS_WOUT), *Wt1 = (bf16_t*)(ws + WS_WT1), *Wt2 = (bf16_t*)(ws + WS_WT2);
    bf16_t *Wup = (bf16_t*)(ws + WS_WUP), *Wdown = (bf16_t*)(ws + WS_WDOWN), *H = (bf16_t*)(ws + WS_H);
    bf16_t *QA = (bf16_t*)(ws + WS_QA), *KA = (bf16_t*)(ws + WS_KA), *QB = (bf16_t*)(ws + WS_QB), *KB = (bf16_t*)(ws + WS_KB), *VT = (bf16_t*)(ws + WS_VT);
    bf16_t *Gt = (bf16_t*)(ws + WS_G), *OA = (bf16_t*)(ws + WS_OA), *OB = (bf16_t*)(ws + WS_OB), *MG = (bf16_t*)(ws + WS_MG), *XG = (bf16_t*)(ws + WS_XG), *U = (bf16_t*)(ws + WS_U);
    bf16_t* MGT = (bf16_t*)(ws + WS_MGT);
    const int lo = args.ph_lo, hi = args.ph_hi;
    const int gw = vcu * NWAVES + wave, NGW = G * NWAVES;
#ifndef PH_MASK
#define PH_MASK 0xff
#endif
#define IN(k) (((PH_MASK >> (k)) & 1) && lo <= (k) && (k) < hi)
#define SEAM(k) do { if (IN(k) && IN((k) + 1)) { if (args.pad != 0) cg::this_grid().sync(); else xcd_barrier(xbar); } } while (0)
    XcdBarrier xbar; xbar.bar = (unsigned*)(ws + WS_CTL) + 1024; xbar.x = 0; xbar.st = (volatile LAS unsigned*)(lds + LDS_BAR_OFF);
    if (hi - lo > 1) {
        if (tid < 3) ((volatile LAS unsigned*)(lds + LDS_BAR_OFF))[tid] = 0u;
        __syncthreads();
        xbar = xcd_barrier_post((unsigned*)(ws + WS_CTL) + 1024, (volatile LAS unsigned*)(lds + LDS_BAR_OFF));
    }

    if (IN(0)) {
        LAS float* scr = (LAS float*)(lds + wave * P0_SCR_STRIDE);
        LAS float* wf = (LAS float*)(lds + P0_WF_OFF);
        if (bx == 0) { if (tid < 64) { GN[tid] = qn_diff[tid] * (0.125f * LOG2E); GN[128 + tid] = kn_diff[tid]; } if (tid < 128) { GN[256 + tid] = qn_fox[tid] * (0.08838834764831845f * LOG2E); GN[384 + tid] = kn_fox[tid]; } }
        for (int k = tid; k < DM; k += NTHREADS) { const f32x4 a = *(const f32x4*)(w_in + (size_t)k * NPROJ + 6144), b = *(const f32x4*)(w_in + (size_t)k * NPROJ + 6148);
            wf[0 * DM + k] = a[0]; wf[1 * DM + k] = a[1]; wf[2 * DM + k] = a[2]; wf[3 * DM + k] = a[3]; wf[4 * DM + k] = b[0]; wf[5 * DM + k] = b[1]; wf[6 * DM + k] = b[2]; wf[7 * DM + k] = b[3]; }
        __syncthreads();
        constexpr int I0 = 2048, I1 = 2048, I2 = 4096, I3 = 1024, I4 = 1024, NIT = I0 + I1 + I2 + I3 + I4;
        for (int it = gw; it < NIT; it += NGW) {
            int q = it;
            if (q < I0) { transpose_item(w_in, NPROJ, 0, 2048, DM, Wt1, 0, scr, q, lane); continue; } q -= I0;
            if (q < I1) { transpose_item(w_in, NPROJ, 3072, 2048, DM, Wt1, 2048, scr, q, lane); continue; } q -= I1;
            if (q < I2) { transpose_item(w_gate, 4096, 0, 4096, DM, Wt1, 4096, scr, q, lane); continue; } q -= I2;
            if (q < I3) { transpose_item(w_in, NPROJ, 2048, 1024, DM, Wt2, 0, scr, q, lane); continue; } q -= I3;
            transpose_item(w_in, NPROJ, 5120, 1024, DM, Wt2, 1024, scr, q, lane);
        }
        for (int row = gw; row < SEQ; row += NGW) {
            const f32x4* xr = (const f32x4*)(x + (size_t)row * DM) + lane;
            f32x4 v[8]; float s = 0.f;
#pragma unroll
            for (int j = 0; j < 8; ++j) { v[j] = xr[64 * j]; s += (v[j][0] * v[j][0] + v[j][1] * v[j][1]) + (v[j][2] * v[j][2] + v[j][3] * v[j][3]); }
            const float rinv = fast_rsq(wave_sum(s) * (1.f / DM) + EPS);
            float a0 = 0.f, a1 = 0.f, a2 = 0.f, a3 = 0.f, a4 = 0.f, a5 = 0.f, a6 = 0.f, a7 = 0.f;
            u32x2* hp = (u32x2*)(H + (size_t)row * DM) + lane;
#pragma unroll
            for (int j = 0; j < 8; ++j) { const f32x4 gg = ((const f32x4*)norm_mix)[lane + 64 * j]; const f32x4 hv = v[j] * rinv * gg;
                u32x2 o; o.x = cvt_pk_bf16(hv[0], hv[1]); o.y = cvt_pk_bf16(hv[2], hv[3]); hp[64 * j] = o;
                const LAS f32x4* wp = (const LAS f32x4*)wf + lane + 64 * j;
#define FDOT(acc_, jj) { const f32x4 w4 = wp[(jj) * (DM / 4)]; acc_ += (hv[0] * w4[0] + hv[1] * w4[1]) + (hv[2] * w4[2] + hv[3] * w4[3]); }
                FDOT(a0, 0) FDOT(a1, 1) FDOT(a2, 2) FDOT(a3, 3) FDOT(a4, 4) FDOT(a5, 5) FDOT(a6, 6) FDOT(a7, 7)
                asm volatile("" ::: "memory");
#undef FDOT
            }
            a0 = wave_sum(a0); a1 = wave_sum(a1); a2 = wave_sum(a2); a3 = wave_sum(a3); a4 = wave_sum(a4); a5 = wave_sum(a5); a6 = wave_sum(a6); a7 = wave_sum(a7);
            if (lane < 8) { float z = lane == 0 ? a0 : lane == 1 ? a1 : lane == 2 ? a2 : lane == 3 ? a3 : lane == 4 ? a4 : lane == 5 ? a5 : lane == 6 ? a6 : a7;
                z += b_forget[lane]; LF[(size_t)lane * SEQ + row] = fminf(z, 0.f) - log1pf(expf(-fabsf(z))); }
        }
        __syncthreads();
    }
    SEAM(0);

    if (IN(1)) {
        {
            pg8::Gemm g{H, Wt2, Wt1, H, DM};
            pg8::P1Order S{G, bx};
            pg8::EpiP1 E{QA, Gt, VT, GN, b_gate};
            pg8::gemm_phase(lds, g, S, E);
        }
        __syncthreads();
        if (bx < 8) {
            LAS double* wsum = (LAS double*)lds;
            const int j = bx; float vals[16]; double s = 0.0;
#pragma unroll
            for (int i = 0; i < 16; ++i) { vals[i] = LF[(size_t)j * SEQ + 16 * tid + i]; s += (double)vals[i]; }
            double inc = s;
#pragma unroll
            for (int o = 1; o < 64; o <<= 1) { const double t = __shfl_up(inc, o); if (lane >= o) inc += t; }
            if (lane == 63) wsum[wave] = inc;
            __syncthreads();
            double run = inc - s;
            for (int q = 0; q < wave; ++q) run += wsum[q];
#pragma unroll
            for (int i = 0; i < 16; ++i) { run += (double)vals[i]; C2[(size_t)j * SEQ + 16 * tid + i] = (float)(-run * (double)LOG2E); }
            __syncthreads();
        }
    }
    SEAM(1);

    if (IN(2)) {
        float lam;
        { const float p1 = wave_sum(lq1[lane] * lk1[lane]), p2 = wave_sum(lq2[lane] * lk2[lane]); lam = expf(p1) - expf(p2) + 0.2f; }
        unsigned* ctl = (unsigned*)(ws + WS_CTL);
        LAS unsigned* qh = (LAS unsigned*)(lds + 8 * 16640 + 64);
        constexpr int TR_IU = 32 * 128, TR_ID = 128 * 32, TR_IB = 16 * 32, TR_IO = 32 * 32, TR_NQ = TR_IU + TR_ID + 2 * TR_IB + TR_IO;
#define TR_ROUNDS(n) do { int lane_ = lane, wave_ = wave; asm volatile("" : "+v"(lane_), "+s"(wave_));     \
        LAS float* scr_ = (LAS float*)(lds + wave_ * 16640); LAS unsigned* qh2_ = (LAS unsigned*)(lds + 8 * 16640); \
        for (int rd_ = 0; rd_ < (n); ++rd_) { if (tid == 0) *qh2_ = atomicAdd(ctl + 0, (unsigned)NWAVES); __syncthreads(); const int it0_ = (int)*qh2_; __syncthreads(); if (it0_ >= TR_NQ) break; \
            int q_ = it0_ + wave_; \
            if (q_ < TR_NQ) { if (q_ < TR_IU) transpose_item64(w_up, FF, FF, DM, Wup, scr_, q_, lane_, norm_mlp);     \
                else if ((q_ -= TR_IU) < TR_ID) transpose_item64(w_down, DM, DM, FF, Wdown, scr_, q_, lane_); \
                else if ((q_ -= TR_ID) < TR_IB) transpose_item64(w_bd, DM, DM, 1024, Wbd, scr_, q_, lane_); \
                else if ((q_ -= TR_IB) < TR_IB) transpose_item64(w_bf, DM, DM, 1024, Wbf, scr_, q_, lane_); \
                else transpose_item64(w_out, DM, DM, DM, Wout, scr_, q_ - TR_IB, lane_); } } } while (0)
#define NEXT_JOB(word, step, dst) do { if (tid == 0) *qh = atomicAdd(ctl + (word), (unsigned)(step)); __syncthreads(); dst = (int)*qh; __syncthreads(); } while (0)
#ifndef ATT_SKIP_DIFF
        if (args.att_sel != 2) for (;;) {
            int job; NEXT_JOB(1, 1, job); if (job >= 512) break;
            const int qb = 31 - (job >> 4), r = job & 15;
            att::attn_unit<true>(lds, QA, KA, VT, nullptr, (bf16_t*)out, nullptr, 7 - (r >> 1), qb, r & 1, lam, GN);
            if (args.att_sel == 0) TR_ROUNDS(2);
        }
#endif
#ifndef ATT_SKIP_FOX
        if (args.att_sel != 1) for (;;) {
            int job; NEXT_JOB(2, 1, job); if (job >= 256) break;
            att::attn_unit<false>(lds, QB, KB, VT + (size_t)1024 * SEQ, C2, OB, nullptr, job & 7, 31 - (job >> 3), 0, 0.f, GN);
            if (args.att_sel == 0) TR_ROUNDS(1);
        }
#endif
        if (args.att_sel == 0) TR_ROUNDS(1 << 30);
#undef NEXT_JOB
#undef TR_ROUNDS
    }
    SEAM(2);

    if (IN(3)) {
        const bf16_t* o0 = (const bf16_t*)out; const bf16_t* o1 = o0 + (size_t)SEQ * 1024;
        f32x4 sg[4];
#pragma unroll
        for (int i = 0; i < 4; ++i) sg[i] = *(const f32x4*)(subln + (lane & 7) * 16 + 4 * i) * 0.8f;
        for (int row = gw; row < SEQ; row += NGW) {
            const size_t off = (size_t)row * 1024 + lane * 16;
            f32x4 v[4]; float ss = 0.f;
#pragma unroll
            for (int i = 0; i < 2; ++i) { const u32x4 a = *(const u32x4*)(o0 + off + 8 * i), b = *(const u32x4*)(o1 + off + 8 * i);
                v[2 * i] = (f32x4){bf_lo(a.x) + bf_lo(b.x), bf_hi(a.x) + bf_hi(b.x), bf_lo(a.y) + bf_lo(b.y), bf_hi(a.y) + bf_hi(b.y)};
                v[2 * i + 1] = (f32x4){bf_lo(a.z) + bf_lo(b.z), bf_hi(a.z) + bf_hi(b.z), bf_lo(a.w) + bf_lo(b.w), bf_hi(a.w) + bf_hi(b.w)}; }
#pragma unroll
            for (int i = 0; i < 4; ++i) ss += (v[i][0] * v[i][0] + v[i][1] * v[i][1]) + (v[i][2] * v[i][2] + v[i][3] * v[i][3]);
            ss += __shfl_xor(ss, 1); ss += __shfl_xor(ss, 2); ss += __shfl_xor(ss, 4);
            const float rinv = fast_rsq(ss * (1.f / 128.f) + EPS);
#pragma unroll
            for (int i = 0; i < 4; ++i) v[i] = v[i] * rinv * sg[i];
            *(u32x4*)(OA + off) = pack8(v[0], v[1]); *(u32x4*)(OA + off + 8) = pack8(v[2], v[3]);
        }
    }


    SEAM(3);

    if (IN(4)) {
        pg8::Gemm g{OA, OB, Wbd, Wbf, 1024};
        pg8::P3Order S{G, bx};
        pg8::EpiP3 E{Gt, MGT, MG};
        pg8::gemm_phase(lds, g, S, E);
    }
    SEAM(4);

    if (IN(5)) {
        pg8::Gemm g{MG, MG, Wout, Wout, DM};
        pg8::PlainOrder S{32, 8, G, bx};
        pg8::EpiP4 E{x, (bf16_t*)(ws + WS_X1B), SS2};
        pg8::gemm_phase(lds, g, S, E);
    }
    SEAM(5);

    if (IN(6)) {
        pg8::Gemm g{(const bf16_t*)(ws + WS_X1B), (const bf16_t*)(ws + WS_X1B), Wup, Wup, DM};
        pg8::PlainOrder S{32, 32, G, bx};
        pg8::Unit u0; int pm0 = -1;
        if (S.next(0, u0)) { pm0 = u0.pm;
            LAS float* tab = (LAS float*)(lds + EPI_SCR_OFF);
            if (tid < 256) { const f32x4* sp = (const f32x4*)(SS2 + (size_t)(pm0 * 256 + tid) * 32); f32x4 sa = sp[0];
#pragma unroll
                for (int q = 1; q < 8; ++q) sa += sp[q];
                tab[tid] = fast_rsq(((sa[0] + sa[1]) + (sa[2] + sa[3])) * (1.f / DM) + EPS); }
            __syncthreads(); }
        pg8::EpiP5 E{SS2, U, pm0};
        pg8::gemm_phase(lds, g, S, E);
    }
    SEAM(6);

    if (IN(7)) {
        pg8::Gemm g{U, U, Wdown, Wdown, FF};
        pg8::PlainOrder S{32, 8, G, bx};
        pg8::EpiP6 E{(const bf16_t*)(ws + WS_X1B), out};
        pg8::gemm_phase(lds, g, S, E);
    }
#undef IN
#undef SEAM
}

#ifdef PROBE_PHASE
__global__ void dump_bf16(const bf16_t* a, const bf16_t* b, float* dst, size_t nhalf) {
    for (size_t i = blockIdx.x * (size_t)blockDim.x + threadIdx.x; i < nhalf; i += (size_t)gridDim.x * blockDim.x) { dst[i] = bf_lo((unsigned)a[i]); dst[nhalf + i] = bf_lo((unsigned)b[i]); }
}
#endif
extern "C" void kernel_launch(void* const* d_in, const int* in_sizes, int n_in, void* d_out, int out_size, void* d_ws, size_t ws_size, hipStream_t stream) {
    static int grid = 0;
    if (grid == 0) {
        if (n_in != 21 || out_size != SEQ * DM || ws_size < WS_END) { fprintf(stderr, "kernel_launch: unexpected problem (n_in %d, out %d, ws %zu)\n", n_in, out_size, ws_size); grid = -1; return; }
        int dev = 0, cus = 0, per_cu = 0;
        hipGetDevice(&dev);
        hipDeviceGetAttribute(&cus, hipDeviceAttributeMultiprocessorCount, dev);
        hipFuncSetAttribute((const void*)fwd_kernel, hipFuncAttributeMaxDynamicSharedMemorySize, LDS_BYTES);
        hipOccupancyMaxActiveBlocksPerMultiprocessor(&per_cu, (const void*)fwd_kernel, NTHREADS, LDS_BYTES);
        if (per_cu < 1) { fprintf(stderr, "kernel_launch: occupancy query says %d blocks per CU\n", per_cu); per_cu = 1; }
        if (per_cu > 1) per_cu = 1;
        grid = cus * per_cu;
        (void)hipGetLastError();
    }
    if (grid < 0) return;
    (void)hipMemsetAsync((char*)d_ws + WS_CTL, 0, CTL_BYTES, stream);
    Args a{};
    for (int i = 0; i < 21; ++i) a.in[i] = (const float*)d_in[i];
    a.out = (float*)d_out; a.ws = (unsigned char*)d_ws;
#if REPEAT_PHASE >= 0
    for (int p = 0; p < 8; ++p) { a.ph_lo = p; a.ph_hi = p + 1; a.att_sel = 0; hipLaunchKernelGGL(fwd_kernel, dim3(grid), dim3(NTHREADS), LDS_BYTES, stream, a);
        if ((REPEAT_PHASE >> p) & 1) { a.att_sel = REPEAT_PHASE >> 8; (void)hipMemsetAsync((char*)d_ws + WS_CTL, 0, 64, stream); hipLaunchKernelGGL(fwd_kernel, dim3(grid), dim3(NTHREADS), LDS_BYTES, stream, a); } }
#elif MK_N_LAUNCHES == 1
    a.ph_lo = 0; a.ph_hi = 8;
    void* kargs[] = {&a};
    hipError_t e = hipLaunchCooperativeKernel((const void*)fwd_kernel, dim3(grid), dim3(NTHREADS), kargs, LDS_BYTES, stream);
    if (e != hipSuccess) fprintf(stderr, "cooperative launch failed: %s (grid %d)\n", hipGetErrorString(e), grid);
#else
#ifdef PROBE_PHASE
    for (int p = 0; p <= PROBE_PHASE; ++p) { a.ph_lo = p; a.ph_hi = p + 1; hipLaunchKernelGGL(fwd_kernel, dim3(grid), dim3(NTHREADS), LDS_BYTES, stream, a); }
    { const unsigned char* w = (const unsigned char*)d_ws; hipLaunchKernelGGL(dump_bf16, dim3(2048), dim3(256), 0, stream, (const bf16_t*)(w + PROBE_A), (const bf16_t*)(w + PROBE_B), (float*)d_out, (size_t)SEQ * 1024); }
#else
    for (int p = 0; p < 8; ++p) { a.ph_lo = p; a.ph_hi = p + 1; hipLaunchKernelGGL(fwd_kernel, dim3(grid), dim3(NTHREADS), LDS_BYTES, stream, a); }
#endif
#endif
}
```

```cpp
#include <hip/hip_runtime.h>
#include <hip/hip_cooperative_groups.h>
#include <cstdio>
#include <cstdint>
namespace cg = cooperative_groups;

#ifndef REPEAT_PHASE
#define REPEAT_PHASE -1
#endif
#ifndef MK_N_LAUNCHES
#define MK_N_LAUNCHES 1
#endif

#define LAS __attribute__((address_space(3)))
typedef unsigned short bf16_t;
typedef short bf16x8 __attribute__((ext_vector_type(8)));
typedef float f32x4 __attribute__((ext_vector_type(4)));
typedef float f32x16 __attribute__((ext_vector_type(16)));
typedef unsigned u32x4 __attribute__((ext_vector_type(4)));
typedef unsigned u32x2 __attribute__((ext_vector_type(2)));

constexpr int SEQ = 8192, DM = 2048, NPROJ = 6152, FF = 8192;
constexpr float EPS = 1e-6f, LOG2E = 1.4426950408889634f;
constexpr int NTHREADS = 512, NWAVES = 8;

constexpr size_t MiB = 1u << 20;
constexpr size_t WS_LF = 0;
constexpr size_t WS_C2 = 256 * 1024;
constexpr size_t WS_GN = 512 * 1024;
constexpr size_t WS_CTL = 768 * 1024;
constexpr size_t CTL_BYTES = 32768;
constexpr size_t WS_SS2 = 1 * MiB;
constexpr size_t WS_WBD = 8 * MiB, WS_WBF = 12 * MiB, WS_WOUT = 16 * MiB;
constexpr size_t WS_WT1 = 24 * MiB, WS_WUP = 24 * MiB;
constexpr size_t WS_WT2 = 56 * MiB;
constexpr size_t WS_H = 64 * MiB, WS_WDOWN = 64 * MiB;
constexpr size_t WS_QA = 96 * MiB, WS_KA = 112 * MiB, WS_QB = 128 * MiB, WS_KB = 144 * MiB;
constexpr size_t WS_MGT = 96 * MiB;
constexpr size_t WS_VT = 160 * MiB, WS_MG = 160 * MiB;
constexpr size_t WS_G = 192 * MiB;
constexpr size_t WS_OA = 256 * MiB, WS_OB = 272 * MiB, WS_XG = 256 * MiB;
constexpr size_t WS_X1B = 224 * MiB;
constexpr size_t WS_U = 96 * MiB;
constexpr size_t WS_END = 288 * MiB;

constexpr int GEMM_LDS = 131072;
constexpr int EPI_SCR_OFF = GEMM_LDS;
constexpr int LDS_BYTES = GEMM_LDS + 4096 + 1024;
constexpr int LDS_BAR_OFF = LDS_BYTES - 16;
constexpr int P0_SCR_STRIDE = 8704, P0_WF_OFF = 8 * P0_SCR_STRIDE;
static_assert(P0_WF_OFF + 65536 <= LDS_BAR_OFF, "P0 LDS map");

typedef float f32x2_t __attribute__((ext_vector_type(2)));
typedef __bf16 bf16x2_t __attribute__((ext_vector_type(2)));
__device__ __forceinline__ unsigned cvt_pk_bf16(float lo, float hi) { const f32x2_t v = {lo, hi}; const bf16x2_t b = __builtin_convertvector(v, bf16x2_t); return __builtin_bit_cast(unsigned, b); }
__device__ __forceinline__ u32x4 pack8(const f32x4& a, const f32x4& b) { u32x4 w; w.x = cvt_pk_bf16(a[0], a[1]); w.y = cvt_pk_bf16(a[2], a[3]); w.z = cvt_pk_bf16(b[0], b[1]); w.w = cvt_pk_bf16(b[2], b[3]); return w; }
__device__ __forceinline__ float bf_lo(unsigned u) { return __uint_as_float(u << 16); }
__device__ __forceinline__ float bf_hi(unsigned u) { return __uint_as_float(u & 0xffff0000u); }
__device__ __forceinline__ float fast_exp2(float x) { return __builtin_amdgcn_exp2f(x); }
__device__ __forceinline__ float fast_rcp(float x) { return __builtin_amdgcn_rcpf(x); }
__device__ __forceinline__ float fast_rsq(float x) { return __builtin_amdgcn_rsqf(x); }
__device__ __forceinline__ float wave_sum(float v) {
#pragma unroll
    for (int o = 1; o < 64; o <<= 1) v += __shfl_xor(v, o);
    return v;
}
#define LDS_WAIT() asm volatile("s_waitcnt lgkmcnt(0)" ::: "memory")

namespace pg8 {
constexpr int BM = 256, BK = 64, HALF = 128, HTB = HALF * BK * 2, STAGE_BYTES = 8 * HTB, NXCD = 8, WGM = 8;
__host__ __device__ __forceinline__ int lds_byte(int r, int c) { const int st = (r >> 4) * 2 + (c >> 5), rr = r & 15, cc = c & 31, ob = rr * 64 + cc * 2; return st * 1024 + (ob ^ (((ob >> 9) & 1) << 5)); }
__host__ __device__ __forceinline__ void stage_rc(int b, int& R, int& C) { const int st = b / 1024, sb = b % 1024, swz = sb ^ (((sb >> 9) & 1) << 5); R = (st >> 1) * 16 + swz / 64; C = (st & 1) * 32 + (swz % 64) / 2; }
__host__ __device__ __forceinline__ int perm32(int rho) { const int n = rho >> 4, i = rho & 15; return 8 * (i >> 2) + 4 * n + (i & 3); }

struct Unit { int pm, pn, sel; };
struct Gemm { const bf16_t *A0, *A1, *B0, *B1; int K; };

__host__ __device__ __forceinline__ void map_tile(int L, int nM, int nN, Unit& u) {
    const int nwg = nM * nN; int wgid = L;
    { const int q = nwg / NXCD, r = nwg % NXCD, xcd = wgid % NXCD, off = wgid / NXCD; wgid = (xcd < r ? xcd * (q + 1) : r * (q + 1) + (xcd - r) * q) + off; }
    const int nig = WGM * nN, gid = wgid / nig, fm = gid * WGM, gsz = (nM - fm) < WGM ? (nM - fm) : WGM;
    u.pm = fm + ((wgid % nig) % gsz); u.pn = (wgid % nig) / gsz;
}
struct PlainOrder { int nM, nN, G, c;
    __device__ __forceinline__ bool next(int i, Unit& u) const { const long L = (long)i * G + c; if (L >= (long)nM * nN) return false; map_tile((int)L, nM, nN, u); u.sel = 0; return true; } };
struct P1Order { int G, c;
    __device__ __forceinline__ bool next(int i, Unit& u) const { long L = (long)i * G + c; if (L < 1024) { map_tile((int)L, 32, 32, u); u.sel = 0; return true; } L -= 1024; if (L < 256) { map_tile((int)L, 8, 32, u); u.sel = 1; return true; } return false; } };
struct P3Order { int G, c;
    __device__ __forceinline__ bool next(int i, Unit& u) const { const long L = (long)(i >> 1) * G + c; if (L >= 256) return false; map_tile((int)L, 32, 8, u); u.sel = i & 1; return true; } };

template <class Epi, class Sched>
__device__ __forceinline__ void gemm_phase(LAS unsigned char* lds, const Gemm g, const Sched& S, const Epi& E) {
    const int tid = threadIdx.x, wid = __builtin_amdgcn_readfirstlane(tid >> 6), lane = tid & 63, wr = wid >> 2, wc = wid & 3, fr = lane & 15, fq = lane >> 4;
    const int K = g.K, nt = K / BK;
    unsigned voffA[2], voffB[2];
#pragma unroll
    for (int i = 0; i < 2; ++i) { int R, C; stage_rc(tid * 16 + i * 8192, R, C); const int Rb = 64 * (R >> 5) + perm32(R & 31);
        voffA[i] = (unsigned)(R * K + C) * 2u; voffB[i] = (unsigned)(Rb * K + C) * 2u; }
    const size_t kstep = (size_t)(BK * 2);
    const size_t hstep = (size_t)HALF * K * 2;
    const size_t hstepB = (size_t)32 * K * 2;
    const size_t tstep = 2 * hstep;
    const unsigned ldsw = (unsigned)wid * 1024u;
    const int aoff = lds_byte(wr * 64 + fr, fq * 8), boff = lds_byte(wc * 32 + fr, fq * 8);
#define PG8_SA(b, h) (((b) * 2 + (h)) * HTB)
#define PG8_SB(b, h) ((4 + (b) * 2 + (h)) * HTB)
#define PG8_STAGE(bufoff, gbase, voff) do { _Pragma("unroll") for (int _i = 0; _i < 2; ++_i) \
        __builtin_amdgcn_global_load_lds((const unsigned*)((const char*)(gbase) + (voff)[_i]), (LAS unsigned*)(lds + (bufoff) + ldsw + _i * 8192), 16, 0, 0); } while (0)
#define PG8_LDA(dst, b, h) do { _Pragma("unroll") for (int m = 0; m < 4; ++m) _Pragma("unroll") for (int k = 0; k < 2; ++k) dst[m][k] = *(const LAS bf16x8*)(lds + PG8_SA(b, h) + aoff + m * 2048 + k * 1024); } while (0)
#define PG8_LDB(dst, b, h) do { _Pragma("unroll") for (int n = 0; n < 2; ++n) _Pragma("unroll") for (int k = 0; k < 2; ++k) dst[n][k] = *(const LAS bf16x8*)(lds + PG8_SB(b, h) + boff + n * 2048 + k * 1024); } while (0)
#define PG8_MMA(ai, bj, At, Bt) do { __builtin_amdgcn_s_setprio(1); _Pragma("unroll") for (int m = 0; m < 4; ++m) _Pragma("unroll") for (int n = 0; n < 2; ++n) _Pragma("unroll") for (int k = 0; k < 2; ++k) \
        acc[ai][bj][m][n] = __builtin_amdgcn_mfma_f32_16x16x32_bf16(Bt[n][k], At[m][k], acc[ai][bj][m][n], 0, 0, 0); __builtin_amdgcn_s_setprio(0); } while (0)
#define PG8_WAIT_V(n) asm volatile("s_waitcnt vmcnt(" #n ")" ::: "memory")
#define PG8_WAIT_L(n) asm volatile("s_waitcnt lgkmcnt(" #n ")" ::: "memory")
#define PG8_BAR __builtin_amdgcn_s_barrier()
#define PG8_SCHED __builtin_amdgcn_sched_barrier(0)
    Unit cur, nxt; int ui = 0;
    if (!S.next(0, cur)) return;
    f32x4 acc[2][2][4][2];
#pragma unroll
    for (int a = 0; a < 2; ++a)
#pragma unroll
        for (int b = 0; b < 2; ++b)
#pragma unroll
            for (int m = 0; m < 4; ++m)
#pragma unroll
                for (int n = 0; n < 2; ++n) acc[a][b][m][n] = (f32x4){0.f, 0.f, 0.f, 0.f};
    bf16x8 At[4][2], B0[2][2], B1[2][2];
    const char* cA = (const char*)(cur.sel ? g.A1 : g.A0) + (size_t)cur.pm * tstep; const char* cB = (const char*)(cur.sel ? g.B1 : g.B0) + (size_t)cur.pn * tstep;
    PG8_STAGE(PG8_SB(0, 0), cB, voffB); PG8_STAGE(PG8_SB(0, 1), cB + hstepB, voffB); PG8_STAGE(PG8_SA(0, 0), cA, voffA); PG8_STAGE(PG8_SA(0, 1), cA + hstep, voffA);
    if (wr == 1) PG8_BAR;
    PG8_WAIT_V(2); PG8_BAR;
    PG8_STAGE(PG8_SB(1, 0), cB + kstep, voffB); PG8_STAGE(PG8_SA(1, 0), cA + kstep, voffA); PG8_STAGE(PG8_SB(1, 1), cB + hstepB + kstep, voffB);
    PG8_WAIT_V(6); PG8_BAR;
    for (;;) {
        const bool has_next = S.next(ui + 1, nxt);
        const char* nA = has_next ? (const char*)(nxt.sel ? g.A1 : g.A0) + (size_t)nxt.pm * tstep : cA; const char* nB = has_next ? (const char*)(nxt.sel ? g.B1 : g.B0) + (size_t)nxt.pn * tstep : cB;
        for (int t = 0; t < nt; t += 2) {
            const bool last = (t == nt - 2);
            const char* a1 = cA + (size_t)(t + 1) * kstep;
            const char* a2 = last ? nA : cA + (size_t)(t + 2) * kstep; const char* b2 = last ? nB : cB + (size_t)(t + 2) * kstep;
            const char* a3 = a2 + kstep; const char* b3 = b2 + kstep;
            PG8_LDB(B0, 0, 0); PG8_LDB(B1, 0, 1); PG8_SCHED; PG8_LDA(At, 0, 0); PG8_STAGE(PG8_SA(1, 1), a1 + hstep, voffA);
            PG8_WAIT_V(8); PG8_WAIT_L(0); PG8_BAR; PG8_MMA(0, 0, At, B0); PG8_MMA(0, 1, At, B1); PG8_BAR; PG8_SCHED;
            PG8_LDA(At, 0, 1); PG8_STAGE(PG8_SB(0, 0), b2, voffB); PG8_STAGE(PG8_SB(0, 1), b2 + hstepB, voffB); PG8_STAGE(PG8_SA(0, 0), a2, voffA);
            PG8_WAIT_V(8); PG8_WAIT_L(0); PG8_BAR; PG8_MMA(1, 0, At, B0); PG8_MMA(1, 1, At, B1); PG8_BAR; PG8_SCHED;
            PG8_LDB(B0, 1, 0); PG8_LDB(B1, 1, 1); PG8_SCHED; PG8_LDA(At, 1, 0); PG8_STAGE(PG8_SA(0, 1), a2 + hstep, voffA);
            PG8_WAIT_V(8); PG8_WAIT_L(0); PG8_BAR; PG8_MMA(0, 0, At, B0); PG8_MMA(0, 1, At, B1); PG8_BAR; PG8_SCHED;
            PG8_LDA(At, 1, 1); PG8_STAGE(PG8_SB(1, 0), b3, voffB); PG8_STAGE(PG8_SB(1, 1), b3 + hstepB, voffB); PG8_STAGE(PG8_SA(1, 0), a3, voffA);
            PG8_WAIT_V(8); PG8_WAIT_L(0); PG8_BAR; PG8_MMA(1, 0, At, B0); PG8_MMA(1, 1, At, B1); PG8_BAR; PG8_SCHED;
        }
        if (wr == 0) PG8_BAR;
        E(acc, cur, wr, wc, fr, fq, (LAS float*)(lds + EPI_SCR_OFF));
        if (!has_next) break;
#pragma unroll
        for (int a = 0; a < 2; ++a)
#pragma unroll
            for (int b = 0; b < 2; ++b)
#pragma unroll
                for (int m = 0; m < 4; ++m)
#pragma unroll
                    for (int n = 0; n < 2; ++n) acc[a][b][m][n] = (f32x4){0.f, 0.f, 0.f, 0.f};
        cur = nxt; cA = nA; cB = nB; ++ui;
        if (wr == 1) PG8_BAR;
    }
    PG8_WAIT_V(0);
    PG8_BAR;
#undef PG8_SA
#undef PG8_SB
#undef PG8_STAGE
#undef PG8_LDA
#undef PG8_LDB
#undef PG8_MMA
#undef PG8_WAIT_V
#undef PG8_WAIT_L
#undef PG8_BAR
#undef PG8_SCHED
}

typedef f32x4 Acc[2][2][4][2];

struct EpiP1 {
    bf16_t *QA, *G, *VT; const float *GN, *bgate;
    __device__ __forceinline__ void operator()(Acc& acc, const Unit& u, int wr, int wc, int fr, int fq, LAS float* scr) const {
        const int colw = 64 * wc + 8 * fq, rowl = wr * 64 + fr;
        if (u.sel == 1) {
            const int tok0 = u.pn * BM + colw;
#pragma unroll
            for (int ai = 0; ai < 2; ++ai)
#pragma unroll
                for (int m = 0; m < 4; ++m) { const int vd = u.pm * BM + rowl + ai * HALF + m * 16;
#pragma unroll
                    for (int bj = 0; bj < 2; ++bj) { const int tok = tok0 + 32 * bj;
                        *(u32x4*)(VT + ((size_t)((vd >> 7) * 128 + (tok >> 6)) * 8192 + (vd & 127) * 64 + (tok & 63))) = pack8(acc[ai][bj][m][0], acc[ai][bj][m][1]); } }
            return;
        }
        if (u.pn >= 16) {
            const int gcol = (u.pn - 16) * BM + colw;
            f32x4 bv[2][2];
#pragma unroll
            for (int bj = 0; bj < 2; ++bj)
#pragma unroll
                for (int n = 0; n < 2; ++n) bv[bj][n] = *(const f32x4*)(bgate + gcol + 32 * bj + 4 * n);
            bf16_t* base = G + (size_t)(u.pm * BM + rowl) * 4096 + gcol;
#pragma unroll
            for (int ai = 0; ai < 2; ++ai)
#pragma unroll
                for (int m = 0; m < 4; ++m) { bf16_t* rp = base + (size_t)(ai * HALF + m * 16) * 4096;
#pragma unroll
                    for (int bj = 0; bj < 2; ++bj) { f32x4 v[2];
#pragma unroll
                        for (int n = 0; n < 2; ++n)
#pragma unroll
                            for (int j = 0; j < 4; ++j) { const float z = acc[ai][bj][m][n][j] + bv[bj][n][j]; v[n][j] = fast_rcp(1.f + fast_exp2(-z * LOG2E)); }
                        *(u32x4*)(rp + 32 * bj) = pack8(v[0], v[1]); } }
            return;
        }
        const int t = u.pn >> 2; const bool fox = t >= 2;
        bf16_t* O = QA + (size_t)t * (8u << 20);
        const float* gn = GN + t * 128;
        const int d0 = (fox ? 64 * (wc & 1) : 0) + 8 * fq;
        f32x4 gv[2][2];
#pragma unroll
        for (int bj = 0; bj < 2; ++bj)
#pragma unroll
            for (int n = 0; n < 2; ++n) gv[bj][n] = *(const f32x4*)(gn + d0 + 32 * bj + 4 * n);
        float ss[2][4];
#pragma unroll
        for (int ai = 0; ai < 2; ++ai)
#pragma unroll
            for (int m = 0; m < 4; ++m) { float s = 0.f;
#pragma unroll
                for (int bj = 0; bj < 2; ++bj)
#pragma unroll
                    for (int n = 0; n < 2; ++n) { const f32x4 x = acc[ai][bj][m][n]; s += (x[0] * x[0] + x[1] * x[1]) + (x[2] * x[2] + x[3] * x[3]); }
                s += __shfl_xor(s, 16); s += __shfl_xor(s, 32); ss[ai][m] = s; }
        if (fox) {
            if (fq == 0) {
#pragma unroll
                for (int ai = 0; ai < 2; ++ai)
#pragma unroll
                    for (int m = 0; m < 4; ++m) scr[(ai * HALF + rowl + m * 16) * 4 + wc] = ss[ai][m];
            }
            LDS_WAIT(); __builtin_amdgcn_s_barrier(); asm volatile("" ::: "memory");
#pragma unroll
            for (int ai = 0; ai < 2; ++ai)
#pragma unroll
                for (int m = 0; m < 4; ++m) ss[ai][m] += scr[(ai * HALF + rowl + m * 16) * 4 + (wc ^ 1)];
            LDS_WAIT();
        }
        const float inv = fox ? (1.f / 128.f) : (1.f / 64.f);
        const bool isk = (t & 1) != 0; const int wsh = fox ? 7 : 6;
#pragma unroll
        for (int ai = 0; ai < 2; ++ai)
#pragma unroll
            for (int m = 0; m < 4; ++m) { const float rinv = fast_rsq(ss[ai][m] * inv + EPS); const int tok = u.pm * BM + rowl + ai * HALF + m * 16;
#pragma unroll
                for (int bj = 0; bj < 2; ++bj) { const f32x4 v0 = acc[ai][bj][m][0] * rinv * gv[bj][0], v1 = acc[ai][bj][m][1] * rinv * gv[bj][1];
                    const int col = (u.pn & 3) * BM + colw + 32 * bj;
                    const size_t off = isk ? ((size_t)((col >> wsh) * 128 + (tok >> 6)) << (6 + wsh)) + ((tok & 63) << wsh) + (col & ((1 << wsh) - 1)) : (size_t)tok * 1024 + col;
                    *(u32x4*)(O + off) = pack8(v0, v1); } }
    }
};

struct EpiP3 {
    const bf16_t* G; bf16_t* MGT; bf16_t* MG;
    __device__ __forceinline__ void operator()(Acc& acc, const Unit& u, int wr, int wc, int fr, int fq, LAS float*) const {
        const int col = u.pn * BM + 64 * wc + 8 * fq, row0 = u.pm * BM + wr * 64 + fr;
#pragma unroll
        for (int ai = 0; ai < 2; ++ai)
#pragma unroll
            for (int m = 0; m < 4; ++m) { const size_t row = (size_t)(row0 + ai * HALF + m * 16);
#pragma unroll
                for (int bj = 0; bj < 2; ++bj) { const int c = col + 32 * bj;
                    const u32x4 gw = *(const u32x4*)(G + row * 4096 + (u.sel ? 2048 : 0) + c);
                    const f32x4 g0 = {bf_lo(gw.x), bf_hi(gw.x), bf_lo(gw.y), bf_hi(gw.y)}, g1 = {bf_lo(gw.z), bf_hi(gw.z), bf_lo(gw.w), bf_hi(gw.w)};
                    f32x4 v0 = acc[ai][bj][m][0] * g0, v1 = acc[ai][bj][m][1] * g1;
                    bf16_t* tp = MGT + row * DM + c;
                    if (u.sel == 0) { *(u32x4*)tp = pack8(v0, v1); }
                    else { const u32x4 tw = *(const u32x4*)tp;
                        v0 += (f32x4){bf_lo(tw.x), bf_hi(tw.x), bf_lo(tw.y), bf_hi(tw.y)}; v1 += (f32x4){bf_lo(tw.z), bf_hi(tw.z), bf_lo(tw.w), bf_hi(tw.w)};
                        *(u32x4*)(MG + row * DM + c) = pack8(v0, v1); } } }
    }
};

struct EpiP4 {
    const float* x; bf16_t* X1B; float* SS2;
    __device__ __forceinline__ void operator()(Acc& acc, const Unit& u, int wr, int wc, int fr, int fq, LAS float*) const {
        const int col = u.pn * BM + 64 * wc + 8 * fq, row0 = u.pm * BM + wr * 64 + fr;
#pragma unroll
        for (int ai = 0; ai < 2; ++ai)
#pragma unroll
            for (int m = 0; m < 4; ++m) { const size_t row = (size_t)(row0 + ai * HALF + m * 16); float s = 0.f;
#pragma unroll
                for (int bj = 0; bj < 2; ++bj) { const size_t o = row * DM + col + 32 * bj;
                    const f32x4 v0 = acc[ai][bj][m][0] + *(const f32x4*)(x + o), v1 = acc[ai][bj][m][1] + *(const f32x4*)(x + o + 4);
                    *(u32x4*)(X1B + o) = pack8(v0, v1);
                    s += (v0[0] * v0[0] + v0[1] * v0[1]) + (v0[2] * v0[2] + v0[3] * v0[3]) + (v1[0] * v1[0] + v1[1] * v1[1]) + (v1[2] * v1[2] + v1[3] * v1[3]); }
                s += __shfl_xor(s, 16); s += __shfl_xor(s, 32);
                if (fq == 0) SS2[row * 32 + u.pn * 4 + wc] = s; }
    }
};

struct EpiP5 {
    const float* SS2; bf16_t* U; int pm0;
    __device__ __forceinline__ void operator()(Acc& acc, const Unit& u, int wr, int wc, int fr, int fq, LAS float* scr) const {
        const int col = u.pn * BM + 64 * wc + 8 * fq, row0 = u.pm * BM + wr * 64 + fr;
#pragma unroll
        for (int ai = 0; ai < 2; ++ai)
#pragma unroll
            for (int m = 0; m < 4; ++m) { const size_t row = (size_t)(row0 + ai * HALF + m * 16);
                float rinv;
                if (u.pm == pm0) rinv = scr[wr * 64 + fr + ai * HALF + m * 16];
                else { const f32x4* sp = (const f32x4*)(SS2 + row * 32); f32x4 sa = sp[0];
#pragma unroll
                    for (int q = 1; q < 8; ++q) sa += sp[q];
                    rinv = fast_rsq(((sa[0] + sa[1]) + (sa[2] + sa[3])) * (1.f / DM) + EPS); }
#pragma unroll
                for (int bj = 0; bj < 2; ++bj) { f32x4 v[2];
#pragma unroll
                    for (int n = 0; n < 2; ++n)
#pragma unroll
                        for (int j = 0; j < 4; ++j) { const float z = fmaxf(acc[ai][bj][m][n][j] * rinv, 0.f); v[n][j] = z * z; }
                    *(u32x4*)(U + row * FF + col + 32 * bj) = pack8(v[0], v[1]); } }
    }
};

struct EpiP6 {
    const bf16_t* X1B; float* out;
    __device__ __forceinline__ void operator()(Acc& acc, const Unit& u, int wr, int wc, int fr, int fq, LAS float*) const {
        const int col = u.pn * BM + 64 * wc + 8 * fq, row0 = u.pm * BM + wr * 64 + fr;
#pragma unroll
        for (int ai = 0; ai < 2; ++ai)
#pragma unroll
            for (int m = 0; m < 4; ++m) { const size_t row = (size_t)(row0 + ai * HALF + m * 16);
#pragma unroll
                for (int bj = 0; bj < 2; ++bj) { const size_t o = row * DM + col + 32 * bj; const u32x4 xw = *(const u32x4*)(X1B + o);
                    const f32x4 v0 = acc[ai][bj][m][0] + (f32x4){bf_lo(xw.x), bf_hi(xw.x), bf_lo(xw.y), bf_hi(xw.y)}, v1 = acc[ai][bj][m][1] + (f32x4){bf_lo(xw.z), bf_hi(xw.z), bf_lo(xw.w), bf_hi(xw.w)};
                    *(f32x4*)(out + o) = v0; *(f32x4*)(out + o + 4) = v1; } }
    }
};
}

__device__ __forceinline__ void transpose_item(const float* __restrict__ W, int ld, int col0, int ncols, int K, bf16_t* WT, int row_off, LAS float* scr, int item, int lane) {
    const int nblk = ncols / 32, kb = item / nblk, nb = item % nblk, k0 = 64 * kb, n0 = 32 * nb;
    const float* wp = W + (size_t)(k0 + (lane >> 5)) * ld + col0 + n0 + (lane & 31);
    LAS float* sp = scr + (lane >> 5) * 33 + (lane & 31);
#pragma unroll 4
    for (int i = 0; i < 32; ++i) { sp[i * 66] = *wp; wp += 2 * ld; }
    LDS_WAIT();
    const int c = lane & 7;
#pragma unroll
    for (int j = 0; j < 4; ++j) { const int n = (lane >> 3) + 8 * j; const LAS float* s = scr + (8 * c) * 33 + n;
        u32x4 o; o.x = cvt_pk_bf16(s[0 * 33], s[1 * 33]); o.y = cvt_pk_bf16(s[2 * 33], s[3 * 33]); o.z = cvt_pk_bf16(s[4 * 33], s[5 * 33]); o.w = cvt_pk_bf16(s[6 * 33], s[7 * 33]);
        *(u32x4*)(WT + (size_t)(row_off + n0 + n) * K + k0 + 8 * c) = o; }
    LDS_WAIT();
}

__device__ __forceinline__ void transpose_item64(const float* __restrict__ W, int ld, int ncols, int K, bf16_t* WT, LAS float* scr, int item, int lane, const float* ks = nullptr) {
    const int nblk = ncols / 64, kb = item / nblk, nb = item % nblk, k0 = 64 * kb, n0 = 64 * nb;
    const float* wp = W + (size_t)(k0 + (lane >> 4)) * ld + n0 + 4 * (lane & 15);
    f32x4 v[16];
#pragma unroll
    for (int i = 0; i < 16; ++i) v[i] = *(const f32x4*)(wp + (size_t)(4 * i) * ld);
    if (ks) {
#pragma unroll
        for (int i = 0; i < 16; ++i) v[i] = v[i] * ks[k0 + 4 * i + (lane >> 4)]; }
    LAS float* sp = scr + (lane >> 4) * 65 + 4 * (lane & 15);
#pragma unroll
    for (int i = 0; i < 16; ++i) { sp[(4 * i) * 65 + 0] = v[i][0]; sp[(4 * i) * 65 + 1] = v[i][1]; sp[(4 * i) * 65 + 2] = v[i][2]; sp[(4 * i) * 65 + 3] = v[i][3]; }
    LDS_WAIT();
    const int c = lane >> 3;
#pragma unroll
    for (int j = 0; j < 8; ++j) { const int n = (lane & 7) + 8 * j; const LAS float* s = scr + (8 * c) * 65 + n;
        u32x4 o; o.x = cvt_pk_bf16(s[0 * 65], s[1 * 65]); o.y = cvt_pk_bf16(s[2 * 65], s[3 * 65]); o.z = cvt_pk_bf16(s[4 * 65], s[5 * 65]); o.w = cvt_pk_bf16(s[6 * 65], s[7 * 65]);
        *(u32x4*)(WT + (size_t)(n0 + n) * K + k0 + 8 * c) = o; }
    LDS_WAIT();
}

namespace att {
constexpr int VROW = 144, BUF = 36864;
static_assert(2 * BUF <= GEMM_LDS, "attention LDS map");
#define MFMA32(a, b, c) __builtin_amdgcn_mfma_f32_32x32x16_bf16((a), (b), (c), 0, 0, 0)

__device__ __forceinline__ void pack_p(const f32x16& S, bf16x8 (&pf)[2]) {
#pragma unroll
    for (int s = 0; s < 2; ++s) { u32x4 p; p.x = cvt_pk_bf16(S[8 * s + 0], S[8 * s + 1]); p.y = cvt_pk_bf16(S[8 * s + 2], S[8 * s + 3]); p.z = cvt_pk_bf16(S[8 * s + 4], S[8 * s + 5]); p.w = cvt_pk_bf16(S[8 * s + 6], S[8 * s + 7]);
        pf[s] = __builtin_bit_cast(bf16x8, p); }
}
constexpr float PRUNE_THR = 80.f;
template <bool DIFF>
__device__ __forceinline__ void attn_unit(LAS unsigned char* lds, const bf16_t* __restrict__ Q, const bf16_t* __restrict__ Kg, const bf16_t* __restrict__ Vt, const float* __restrict__ c2g,
                                          bf16_t* Og, float* park, int head, int qb, int mp, float lam, const float* GN, const bool both = false, bf16_t* OAf = nullptr, const float* subln = nullptr) {
    constexpr int NX = DIFF ? 4 : 8, KROW = DIFF ? 144 : 272, V_OFF = 64 * KROW, C2_OFF = V_OFF + 128 * VROW;
    static_assert(C2_OFF + 256 <= BUF, "attention buffer");
    const int tid = threadIdx.x, lane = tid & 63, w = __builtin_amdgcn_readfirstlane(tid >> 6), r = lane & 31, h = lane >> 5;
    const int trow = qb * 256 + 32 * w + r;
    const int jmax = 4 * qb + 3, jd = 4 * qb + (w >> 1);
    const int toff = 32 * (w & 1) + r;
    const float slope2 = DIFF ? exp2f(-(float)(head + 1)) * LOG2E : 0.f;
    const bf16_t* gV = Vt + (size_t)head * 128 * 8192 + tid * 8;
    const unsigned lV = V_OFF + (tid >> 3) * VROW + (tid & 7) * 16;
    const unsigned lK = DIFF ? (tid >> 3) * KROW + (tid & 7) * 16 : (tid >> 4) * KROW + (tid & 15) * 16;
    const int kap = (r & ~12) | ((r & 4) << 1) | ((r & 8) >> 1);
    const unsigned rK = kap * KROW + 16 * h, rV = V_OFF + r * VROW + 16 * h;
    f32x16 O[4];
    int jmin = 0;
    if (DIFF) {
        float gq = fabsf(GN[lane]), gk = fabsf(GN[128 + lane]);
#pragma unroll
        for (int o = 1; o < 64; o <<= 1) { gq = fmaxf(gq, __shfl_xor(gq, o)); gk = fmaxf(gk, __shfl_xor(gk, o)); }
        const float B2 = 2.f * 1.05f * 64.f * gq * gk;
        const float dmax = (PRUNE_THR + B2) / slope2;
        const float jf = ceilf(((float)(256 * qb - 63) - dmax) * (1.f / 64.f));
        jmin = jf > 0.f ? (int)jf : 0;
    } else {
        float gq = fmaxf(fabsf(GN[256 + lane]), fabsf(GN[320 + lane])), gk = fmaxf(fabsf(GN[384 + lane]), fabsf(GN[448 + lane]));
#pragma unroll
        for (int o = 1; o < 64; o <<= 1) { gq = fmaxf(gq, __shfl_xor(gq, o)); gk = fmaxf(gk, __shfl_xor(gk, o)); }
        const float B2 = 2.f * 1.05f * 128.f * gq * gk;
        const float cref = c2g[head * SEQ + 256 * qb];
        const int j0 = lane, j1 = lane + 64;
        const bool n0 = (j0 <= jmax) && (B2 + c2g[head * SEQ + 64 * (j0 <= jmax ? j0 : 0) + 63] - cref >= -PRUNE_THR);
        const bool n1 = (j1 <= jmax) && (B2 + c2g[head * SEQ + 64 * (j1 <= jmax ? j1 : 0) + 63] - cref >= -PRUNE_THR);
        const unsigned long long b0 = __ballot(n0), b1 = __ballot(n1);
        jmin = b0 ? (__ffsll((long long)b0) - 1) : (b1 ? 64 + __ffsll((long long)b1) - 1 : 4 * qb);
        if (jmin > 4 * qb) jmin = 4 * qb;
    }
    jmin = __builtin_amdgcn_readfirstlane(jmin);
#pragma unroll 1
    for (int pass = 0; pass < (DIFF && both ? 2 : 1); ++pass) {
        const int mpc = (DIFF && both) ? pass : mp;
        bf16x8 qf[NX];
        { const bf16_t* qp = Q + (size_t)trow * 1024 + head * 128 + (DIFF ? 64 * mpc : 0) + 8 * h;
#pragma unroll
          for (int x = 0; x < NX; ++x) qf[x] = *(const bf16x8*)(qp + 16 * x);
#pragma unroll
          for (int x = 0; x < NX; ++x) asm volatile("" : "+v"(qf[x])); }
        const bf16_t* gK = DIFF ? Kg + (size_t)(head * 2 + mpc) * 128 * 4096 + tid * 8 : Kg + (size_t)head * 128 * 8192 + tid * 8;
        u32x4 kreg[2], vreg[2]; float creg = 0.f;
#define ATT_LOAD(j) do { const size_t j_ = (size_t)(j); kreg[0] = *(const u32x4*)(gK + j_ * (DIFF ? 4096 : 8192)); if (!DIFF) kreg[1] = *(const u32x4*)(gK + j_ * 8192 + 4096); \
        vreg[0] = *(const u32x4*)(gV + j_ * 8192); vreg[1] = *(const u32x4*)(gV + j_ * 8192 + 4096); if (!DIFF && tid < 64) creg = c2g[head * SEQ + j_ * 64 + tid]; } while (0)
#define ATT_WRITE(b) do { LAS unsigned char* bp_ = lds + (b) * BUF; *(LAS u32x4*)(bp_ + lK) = kreg[0]; if (!DIFF) *(LAS u32x4*)(bp_ + lK + 32 * KROW) = kreg[1]; \
        *(LAS u32x4*)(bp_ + lV) = vreg[0]; *(LAS u32x4*)(bp_ + lV + 64 * VROW) = vreg[1]; if (!DIFF && tid < 64) *(LAS float*)(bp_ + C2_OFF + tid * 4) = creg; } while (0)
#pragma unroll
        for (int db = 0; db < 4; ++db)
#pragma unroll
            for (int i = 0; i < 16; ++i) O[db][i] = 0.f;
        float m = DIFF ? slope2 * (float)toff : c2g[head * SEQ + trow], l = 0.f;
        asm volatile("" : "+v"(m));
        ATT_LOAD(jmax); ATT_WRITE(0);
        __syncthreads();
        int cur = 0;
        for (int j = jmax; j >= jmin; --j) {
            if (j > jd) { if (j > jmin) ATT_LOAD(j - 1); }
            if (j <= jd) {
                const bool diag = (j == jd);
                const LAS unsigned char* bp = lds + cur * BUF;
                if (__any(l > 1.8446744e19f)) {
                    const float a = 5.421010862e-20f; l *= a; m += 64.f;
#pragma unroll
                    for (int db = 0; db < 4; ++db) O[db] *= a;
                }
                if (DIFF && !diag) m += 64.f * slope2;
                f32x16 S0, S1;
                bf16x8 kfa[NX], kfb[DIFF ? NX : 1];
#pragma unroll
                for (int x = 0; x < NX; ++x) { kfa[x] = *(const LAS bf16x8*)(bp + rK + x * 32); if (DIFF) kfb[x] = *(const LAS bf16x8*)(bp + rK + 32 * KROW + x * 32); }
                asm volatile("" ::: "memory");
                if (DIFF) {
                    if (diag) { int toff_v = toff, h_v = 8 * h; asm volatile("" : "+v"(toff_v), "+v"(h_v)); const float tf = (float)toff_v, hf = (float)h_v, base = slope2 * tf - m;
#pragma unroll
                        for (int i = 0; i < 16; ++i) { const float ko = (float)(16 * (i >> 3) + (i & 7)) + hf; S0[i] = base - slope2 * fabsf(ko - tf); S1[i] = base - slope2 * fabsf(ko + 32.f - tf); } }
                    else { const float base = slope2 * (float)(8 * h) - m;
#pragma unroll
                        for (int i = 0; i < 16; ++i) { S0[i] = fmaf(slope2, (float)(16 * (i >> 3) + (i & 7)), base); S1[i] = fmaf(slope2, (float)(32 + 16 * (i >> 3) + (i & 7)), base); } }
                } else {
                    const LAS f32x4* cp = (const LAS f32x4*)(bp + C2_OFF + (8 * h) * 4);
                    const f32x4 c0 = cp[0], c1 = cp[1], c2v = cp[4], c3 = cp[5], d0 = cp[8], d1 = cp[9], d2 = cp[12], d3 = cp[13];
#pragma unroll
                    for (int i = 0; i < 4; ++i) { S0[i] = c0[i] - m; S0[4 + i] = c1[i] - m; S0[8 + i] = c2v[i] - m; S0[12 + i] = c3[i] - m;
                                                  S1[i] = d0[i] - m; S1[4 + i] = d1[i] - m; S1[8 + i] = d2[i] - m; S1[12 + i] = d3[i] - m; }
                }
                __builtin_amdgcn_s_setprio(2);
                if (DIFF) {
#pragma unroll
                    for (int x = 0; x < NX; ++x) { S0 = MFMA32(kfa[x], qf[x], S0); S1 = MFMA32(kfb[x], qf[x], S1); }
                } else {
#pragma unroll
                    for (int x = 0; x < NX; ++x) S0 = MFMA32(kfa[x], qf[x], S0);
#pragma unroll
                    for (int x = 0; x < NX; ++x) kfa[x] = *(const LAS bf16x8*)(bp + rK + 32 * KROW + x * 32);
                    asm volatile("" ::: "memory");
#pragma unroll
                    for (int x = 0; x < NX; ++x) S1 = MFMA32(kfa[x], qf[x], S1);
                }
                if (j > jmin) ATT_LOAD(j - 1);
                bf16x8 vf0[8], vf1[8];
#pragma unroll
                for (int s = 0; s < 2; ++s)
#pragma unroll
                    for (int db = 0; db < 4; ++db) vf0[s * 4 + db] = *(const LAS bf16x8*)(bp + rV + db * 32 * VROW + s * 32);
                asm volatile("" ::: "memory");
                if (diag) {
                    if (!DIFF) { int toff_v = toff - 8 * h; asm volatile("" : "+v"(toff_v));
#pragma unroll
                        for (int i = 0; i < 16; ++i) { const int ko = 16 * (i >> 3) + (i & 7); if (ko > toff_v) S0[i] = -INFINITY; if (ko + 32 > toff_v) S1[i] = -INFINITY; } }
                    float tm = S0[0];
#pragma unroll
                    for (int i = 1; i < 16; ++i) tm = fmaxf(tm, S0[i]);
#pragma unroll
                    for (int i = 0; i < 16; ++i) tm = fmaxf(tm, S1[i]);
                    tm = fmaxf(tm, __shfl_xor(tm, 32));
                    m += tm;
#pragma unroll
                    for (int i = 0; i < 16; ++i) { S0[i] -= tm; S1[i] -= tm; }
                }
                bf16x8 pf0[2], pf1[2];
                float ls = 0.f;
#pragma unroll
                for (int i = 0; i < 16; ++i) { S0[i] = fast_exp2(S0[i]); ls += S0[i]; }
                pack_p(S0, pf0);
#pragma unroll
                for (int s = 0; s < 2; ++s)
#pragma unroll
                    for (int db = 0; db < 4; ++db) O[db] = MFMA32(vf0[s * 4 + db], pf0[s], O[db]);
#pragma unroll
                for (int s = 0; s < 2; ++s)
#pragma unroll
                    for (int db = 0; db < 4; ++db) vf1[s * 4 + db] = *(const LAS bf16x8*)(bp + rV + db * 32 * VROW + 64 + s * 32);
                asm volatile("" ::: "memory");
#pragma unroll
                for (int i = 0; i < 16; ++i) { S1[i] = fast_exp2(S1[i]); ls += S1[i]; }
                pack_p(S1, pf1);
                l += ls;
#pragma unroll
                for (int s = 0; s < 2; ++s)
#pragma unroll
                    for (int db = 0; db < 4; ++db) O[db] = MFMA32(vf1[s * 4 + db], pf1[s], O[db]);
                __builtin_amdgcn_s_setprio(0);
            }
            if (j > jmin) ATT_WRITE(cur ^ 1);
            __syncthreads();
            cur ^= 1;
        }
        l += __shfl_xor(l, 32);
        const float il = (DIFF && mpc == 1) ? -lam / l : 1.f / l;
#pragma unroll
        for (int db = 0; db < 4; ++db) O[db] *= il;
        if (DIFF && both) {
            float* pk = park + tid * 64;
            if (pass == 0) {
#pragma unroll
                for (int db = 0; db < 4; ++db)
#pragma unroll
                    for (int g = 0; g < 4; ++g) *(f32x4*)(pk + db * 16 + 4 * g) = (f32x4){O[db][4 * g], O[db][4 * g + 1], O[db][4 * g + 2], O[db][4 * g + 3]};
            } else {
#pragma unroll
                for (int db = 0; db < 4; ++db)
#pragma unroll
                    for (int g = 0; g < 4; ++g) { const f32x4 pv = *(const f32x4*)(pk + db * 16 + 4 * g);
#pragma unroll
                        for (int i = 0; i < 4; ++i) O[db][4 * g + i] += pv[i]; }
            }
        }
#undef ATT_LOAD
#undef ATT_WRITE
    }
    asm volatile("" ::: "memory");
    if (DIFF && both) {
        float ss = 0.f;
#pragma unroll
        for (int db = 0; db < 4; ++db)
#pragma unroll
            for (int i = 0; i < 16; ++i) ss += O[db][i] * O[db][i];
        ss += __shfl_xor(ss, 32);
        const float rinv = fast_rsq(ss * (1.f / 128.f) + EPS) * 0.8f;
#pragma unroll
        for (int db = 0; db < 4; ++db)
#pragma unroll
            for (int g = 0; g < 4; ++g) { const f32x4 sgv = *(const f32x4*)(subln + 32 * db + 8 * g + 4 * h);
#pragma unroll
                for (int i = 0; i < 4; ++i) O[db][4 * g + i] *= rinv * sgv[i]; }
    }
    bf16_t* op = ((DIFF && both) ? OAf : Og + (DIFF ? (size_t)mp * ((size_t)SEQ * 1024) : (size_t)0)) + (size_t)trow * 1024 + head * 128 + 4 * h;
#pragma unroll
    for (int db = 0; db < 4; ++db)
#pragma unroll
        for (int g = 0; g < 4; ++g) { u32x2 o; o.x = cvt_pk_bf16(O[db][4 * g], O[db][4 * g + 1]); o.y = cvt_pk_bf16(O[db][4 * g + 2], O[db][4 * g + 3]);
            *(u32x2*)(op + 32 * db + 8 * g) = o; }
}
}

#define XB_TMO      128
#define XB_XCNT(j)  (256  + 64 * (j))
#define XB_XSUB(j)  (1280 + 64 * (j))
#define XB_XGEN(j)  (2304 + 64 * (j))
#define XB_TOP      3328
#define XB_TOPGEN   3392
#define XCD_BAR_WORDS 3456
#define XB_SPIN_CAP (1u << 22)
__device__ __forceinline__ unsigned xb_ld(unsigned* p)              { return __hip_atomic_load(p, __ATOMIC_RELAXED, __HIP_MEMORY_SCOPE_AGENT); }
__device__ __forceinline__ unsigned xb_add(unsigned* p, unsigned v) { return __hip_atomic_fetch_add(p, v, __ATOMIC_RELAXED, __HIP_MEMORY_SCOPE_AGENT); }
__device__ __forceinline__ unsigned xb_xcc_id() { return (unsigned)__builtin_amdgcn_s_getreg((3 << 11) | 20) & 0xFu; }
#define XB_SPIN(cond, bar) do { unsigned _sp = 0; while (cond) { __builtin_amdgcn_s_sleep(1); \
    if ((++_sp & 255u) == 0u) { if (xb_ld(&(bar)[XB_TMO])) break; if (_sp > XB_SPIN_CAP) { atomicAdd(&(bar)[XB_TMO], 1u); break; } } } } while (0)
struct XcdBarrier { unsigned* bar; unsigned x; volatile LAS unsigned* st; };
__device__ __forceinline__ XcdBarrier xcd_barrier_post(unsigned* bar, volatile LAS unsigned* st) {
    XcdBarrier b; b.bar = bar; b.x = xb_xcc_id(); b.st = st;
    if (threadIdx.x == 0) (void)xb_add(&bar[XB_XCNT(b.x)], 1u);
    return b;
}
__device__ __forceinline__ void xcd_barrier_complete(unsigned* bar, unsigned x, unsigned& nloc, unsigned& nx) {
    const unsigned G = gridDim.x * gridDim.y * gridDim.z;
    unsigned sum, cnt, mine, sp = 0u;
    for (;;) {
        sum = 0u; cnt = 0u; mine = 0u;
#pragma unroll
        for (unsigned j = 0; j < 16; ++j) { const unsigned c = xb_ld(&bar[XB_XCNT(j)]); sum += c; cnt += (c > 0u) ? 1u : 0u; mine = (j == x) ? c : mine; }
        if (sum == G) break;
        __builtin_amdgcn_s_sleep(1);
        if ((++sp & 255u) == 0u) { if (xb_ld(&bar[XB_TMO])) break; if (sp > XB_SPIN_CAP) { atomicAdd(&bar[XB_TMO], 1u); break; } }
    }
    nloc = mine > 0u ? mine : 1u; nx = cnt > 0u ? cnt : 1u;
}
__device__ __forceinline__ void xcd_barrier(const XcdBarrier& b) {
    asm volatile("s_waitcnt vmcnt(0)" ::: "memory");
    __syncthreads();
    if (threadIdx.x == 0) {
        unsigned* bar = b.bar;
        __builtin_amdgcn_s_waitcnt(0);
        unsigned nloc = b.st[0], nx = b.st[1];
        if (nloc == 0u) { xcd_barrier_complete(bar, b.x, nloc, nx); b.st[0] = nloc; b.st[1] = nx; }
        const unsigned k = b.st[2]; b.st[2] = k + 1u;
        const unsigned old = xb_add(&bar[XB_XSUB(b.x)], 1u);
        const unsigned gen = old / nloc;
        if (old + 1u == (gen + 1u) * nloc) {
            __builtin_amdgcn_fence(__ATOMIC_RELEASE, "agent");
            asm volatile("s_waitcnt vmcnt(0)" ::: "memory");
            const unsigned og = xb_add(&bar[XB_TOP], 1u);
            const unsigned tg = og / nx;
            if (og + 1u == (tg + 1u) * nx) xb_add(&bar[XB_TOPGEN], 1u);
        }
        XB_SPIN(xb_ld(&bar[XB_TOPGEN]) == k, bar);
        __builtin_amdgcn_fence(__ATOMIC_ACQUIRE, "agent");
        asm volatile("s_waitcnt vmcnt(0)" ::: "memory");
    }
    __syncthreads();
}

struct Args { const float* in[21]; float* out; unsigned char* ws; int ph_lo, ph_hi, att_sel, pad; };

__global__ void __launch_bounds__(NTHREADS, 2) fwd_kernel(Args args) {
    extern __shared__ __attribute__((aligned(16))) unsigned char lds_raw[];
    LAS unsigned char* lds = (LAS unsigned char*)lds_raw;
    const int tid = threadIdx.x, lane = tid & 63, wave = __builtin_amdgcn_readfirstlane(tid >> 6);
    const int G = gridDim.x, bx = blockIdx.x;
    const int vcu = (G % 8 == 0) ? (bx % 8) * (G / 8) + bx / 8 : bx;
    unsigned char* ws = args.ws;
    const float* x = args.in[0];       const float* norm_mix = args.in[1]; const float* w_in = args.in[2];   const float* b_forget = args.in[3];
    const float* qn_diff = args.in[4]; const float* kn_diff = args.in[5];  const float* lq1 = args.in[6];    const float* lk1 = args.in[7];
    const float* lq2 = args.in[8];     const float* lk2 = args.in[9];      const float* subln = args.in[10]; const float* qn_fox = args.in[11];
    const float* kn_fox = args.in[12]; const float* w_bd = args.in[13];    const float* w_bf = args.in[14];  const float* w_gate = args.in[15];
    const float* b_gate = args.in[16]; const float* w_out = args.in[17];   const float* norm_mlp = args.in[18]; const float* w_up = args.in[19];
    const float* w_down = args.in[20];
    float* out = args.out;
    float* LF = (float*)(ws + WS_LF); float* C2 = (float*)(ws + WS_C2); float* SS2 = (float*)(ws + WS_SS2); float* GN = (float*)(ws + WS_GN);
    bf16_t *Wbd = (bf16_t*)(ws + WS_WBD), *Wbf = (bf16_t*)(ws + WS_WBF), *Wout = (bf16_t*)(ws + WS_WOUT), *Wt1 = (bf16_t*)(ws + WS_WT1), *Wt2 = (bf16_t*)(ws + WS_WT2);
    bf16_t *Wup = (bf16_t*)(ws + WS_WUP), *Wdown = (bf16_t*)(ws + WS_WDOWN), *H = (bf16_t*)(ws + WS_H);
    bf16_t *QA = (bf16_t*)(ws + WS_QA), *KA = (bf16_t*)(ws + WS_KA), *QB = (bf16_t*)(ws + WS_QB), *KB = (bf16_t*)(ws + WS_KB), *VT = (bf16_t*)(ws + WS_VT);
    bf16_t *Gt = (bf16_t*)(ws + WS_G), *OA = (bf16_t*)(ws + WS_OA), *OB = (bf16_t*)(ws + WS_OB), *MG = (bf16_t*)(ws + WS_MG), *XG = (bf16_t*)(ws + WS_XG), *U = (bf16_t*)(ws + WS_U);
    bf16_t* MGT = (bf16_t*)(ws + WS_MGT);
    const int lo = args.ph_lo, hi = args.ph_hi;
    const int gw = vcu * NWAVES + wave, NGW = G * NWAVES;
#ifndef PH_MASK
#define PH_MASK 0xff
#endif
#define IN(k) (((PH_MASK >> (k)) & 1) && lo <= (k) && (k) < hi)
#define SEAM(k) do { if (IN(k) && IN((k) + 1)) { if (args.pad != 0) cg::this_grid().sync(); else xcd_barrier(xbar); } } while (0)
    XcdBarrier xbar; xbar.bar = (unsigned*)(ws + WS_CTL) + 1024; xbar.x = 0; xbar.st = (volatile LAS unsigned*)(lds + LDS_BAR_OFF);
    if (hi - lo > 1) {
        if (tid < 3) ((volatile LAS unsigned*)(lds + LDS_BAR_OFF))[tid] = 0u;
        __syncthreads();
        xbar = xcd_barrier_post((unsigned*)(ws + WS_CTL) + 1024, (volatile LAS unsigned*)(lds + LDS_BAR_OFF));
    }

    if (IN(0)) {
        LAS float* scr = (LAS float*)(lds + wave * P0_SCR_STRIDE);
        LAS float* wf = (LAS float*)(lds + P0_WF_OFF);
        if (bx == 0) { if (tid < 64) { GN[tid] = qn_diff[tid] * (0.125f * LOG2E); GN[128 + tid] = kn_diff[tid]; } if (tid < 128) { GN[256 + tid] = qn_fox[tid] * (0.08838834764831845f * LOG2E); GN[384 + tid] = kn_fox[tid]; } }
        for (int k = tid; k < DM; k += NTHREADS) { const f32x4 a = *(const f32x4*)(w_in + (size_t)k * NPROJ + 6144), b = *(const f32x4*)(w_in + (size_t)k * NPROJ + 6148);
            wf[0 * DM + k] = a[0]; wf[1 * DM + k] = a[1]; wf[2 * DM + k] = a[2]; wf[3 * DM + k] = a[3]; wf[4 * DM + k] = b[0]; wf[5 * DM + k] = b[1]; wf[6 * DM + k] = b[2]; wf[7 * DM + k] = b[3]; }
        __syncthreads();
        constexpr int I0 = 2048, I1 = 2048, I2 = 4096, I3 = 1024, I4 = 1024, NIT = I0 + I1 + I2 + I3 + I4;
        for (int it = gw; it < NIT; it += NGW) {
            int q = it;
            if (q < I0) { transpose_item(w_in, NPROJ, 0, 2048, DM, Wt1, 0, scr, q, lane); continue; } q -= I0;
            if (q < I1) { transpose_item(w_in, NPROJ, 3072, 2048, DM, Wt1, 2048, scr, q, lane); continue; } q -= I1;
            if (q < I2) { transpose_item(w_gate, 4096, 0, 4096, DM, Wt1, 4096, scr, q, lane); continue; } q -= I2;
            if (q < I3) { transpose_item(w_in, NPROJ, 2048, 1024, DM, Wt2, 0, scr, q, lane); continue; } q -= I3;
            transpose_item(w_in, NPROJ, 5120, 1024, DM, Wt2, 1024, scr, q, lane);
        }
        for (int row = gw; row < SEQ; row += NGW) {
            const f32x4* xr = (const f32x4*)(x + (size_t)row * DM) + lane;
            f32x4 v[8]; float s = 0.f;
#pragma unroll
            for (int j = 0; j < 8; ++j) { v[j] = xr[64 * j]; s += (v[j][0] * v[j][0] + v[j][1] * v[j][1]) + (v[j][2] * v[j][2] + v[j][3] * v[j][3]); }
            const float rinv = fast_rsq(wave_sum(s) * (1.f / DM) + EPS);
            float a0 = 0.f, a1 = 0.f, a2 = 0.f, a3 = 0.f, a4 = 0.f, a5 = 0.f, a6 = 0.f, a7 = 0.f;
            u32x2* hp = (u32x2*)(H + (size_t)row * DM) + lane;
#pragma unroll
            for (int j = 0; j < 8; ++j) { const f32x4 gg = ((const f32x4*)norm_mix)[lane + 64 * j]; const f32x4 hv = v[j] * rinv * gg;
                u32x2 o; o.x = cvt_pk_bf16(hv[0], hv[1]); o.y = cvt_pk_bf16(hv[2], hv[3]); hp[64 * j] = o;
                const LAS f32x4* wp = (const LAS f32x4*)wf + lane + 64 * j;
#define FDOT(acc_, jj) { const f32x4 w4 = wp[(jj) * (DM / 4)]; acc_ += (hv[0] * w4[0] + hv[1] * w4[1]) + (hv[2] * w4[2] + hv[3] * w4[3]); }
                FDOT(a0, 0) FDOT(a1, 1) FDOT(a2, 2) FDOT(a3, 3) FDOT(a4, 4) FDOT(a5, 5) FDOT(a6, 6) FDOT(a7, 7)
                asm volatile("" ::: "memory");
#undef FDOT
            }
            a0 = wave_sum(a0); a1 = wave_sum(a1); a2 = wave_sum(a2); a3 = wave_sum(a3); a4 = wave_sum(a4); a5 = wave_sum(a5); a6 = wave_sum(a6); a7 = wave_sum(a7);
            if (lane < 8) { float z = lane == 0 ? a0 : lane == 1 ? a1 : lane == 2 ? a2 : lane == 3 ? a3 : lane == 4 ? a4 : lane == 5 ? a5 : lane == 6 ? a6 : a7;
                z += b_forget[lane]; LF[(size_t)lane * SEQ + row] = fminf(z, 0.f) - log1pf(expf(-fabsf(z))); }
        }
        __syncthreads();
    }
    SEAM(0);

    if (IN(1)) {
        {
            pg8::Gemm g{H, Wt2, Wt1, H, DM};
            pg8::P1Order S{G, bx};
            pg8::EpiP1 E{QA, Gt, VT, GN, b_gate};
            pg8::gemm_phase(lds, g, S, E);
        }
        __syncthreads();
        if (bx < 8) {
            LAS double* wsum = (LAS double*)lds;
            const int j = bx; float vals[16]; double s = 0.0;
#pragma unroll
            for (int i = 0; i < 16; ++i) { vals[i] = LF[(size_t)j * SEQ + 16 * tid + i]; s += (double)vals[i]; }
            double inc = s;
#pragma unroll
            for (int o = 1; o < 64; o <<= 1) { const double t = __shfl_up(inc, o); if (lane >= o) inc += t; }
            if (lane == 63) wsum[wave] = inc;
            __syncthreads();
            double run = inc - s;
            for (int q = 0; q < wave; ++q) run += wsum[q];
#pragma unroll
            for (int i = 0; i < 16; ++i) { run += (double)vals[i]; C2[(size_t)j * SEQ + 16 * tid + i] = (float)(-run * (double)LOG2E); }
            __syncthreads();
        }
    }
    SEAM(1);

    if (IN(2)) {
        float lam;
        { const float p1 = wave_sum(lq1[lane] * lk1[lane]), p2 = wave_sum(lq2[lane] * lk2[lane]); lam = expf(p1) - expf(p2) + 0.2f; }
        unsigned* ctl = (unsigned*)(ws + WS_CTL);
        LAS unsigned* qh = (LAS unsigned*)(lds + 8 * 16640 + 64);
        constexpr int TR_IU = 32 * 128, TR_ID = 128 * 32, TR_IB = 16 * 32, TR_IO = 32 * 32, TR_NQ = TR_IU + TR_ID + 2 * TR_IB + TR_IO;
#define TR_ROUNDS(n) do { int lane_ = lane, wave_ = wave; asm volatile("" : "+v"(lane_), "+s"(wave_));     \
        LAS float* scr_ = (LAS float*)(lds + wave_ * 16640); LAS unsigned* qh2_ = (LAS unsigned*)(lds + 8 * 16640); \
        for (int rd_ = 0; rd_ < (n); ++rd_) { if (tid == 0) *qh2_ = atomicAdd(ctl + 0, (unsigned)NWAVES); __syncthreads(); const int it0_ = (int)*qh2_; __syncthreads(); if (it0_ >= TR_NQ) break; \
            int q_ = it0_ + wave_; \
            if (q_ < TR_NQ) { if (q_ < TR_IU) transpose_item64(w_up, FF, FF, DM, Wup, scr_, q_, lane_, norm_mlp);     \
                else if ((q_ -= TR_IU) < TR_ID) transpose_item64(w_down, DM, DM, FF, Wdown, scr_, q_, lane_); \
                else if ((q_ -= TR_ID) < TR_IB) transpose_item64(w_bd, DM, DM, 1024, Wbd, scr_, q_, lane_); \
                else if ((q_ -= TR_IB) < TR_IB) transpose_item64(w_bf, DM, DM, 1024, Wbf, scr_, q_, lane_); \
                else transpose_item64(w_out, DM, DM, DM, Wout, scr_, q_ - TR_IB, lane_); } } } while (0)
#define NEXT_JOB(word, step, dst) do { if (tid == 0) *qh = atomicAdd(ctl + (word), (unsigned)(step)); __syncthreads(); dst = (int)*qh; __syncthreads(); } while (0)
#ifndef ATT_SKIP_DIFF
        if (args.att_sel != 2) for (;;) {
            int job; NEXT_JOB(1, 1, job); if (job >= 512) break;
            const int qb = 31 - (job >> 4), r = job & 15;
            const bool both = r >= 6;
            if (both && (r & 1)) continue;
            att::attn_unit<true>(lds, QA, KA, VT, nullptr, (bf16_t*)out, out + (size_t)SEQ * 1024 + (size_t)bx * (64 * NTHREADS), 7 - (r >> 1), qb, r & 1, lam, GN, both, OA, subln);
            if (args.att_sel == 0) TR_ROUNDS(2);
        }
#endif
#ifndef ATT_SKIP_FOX
        if (args.att_sel != 1) for (;;) {
            int job; NEXT_JOB(2, 1, job); if (job >= 256) break;
            att::attn_unit<false>(lds, QB, KB, VT + (size_t)1024 * SEQ, C2, OB, nullptr, job & 7, 31 - (job >> 3), 0, 0.f, GN);
            if (args.att_sel == 0) TR_ROUNDS(1);
        }
#endif
        if (args.att_sel == 0) TR_ROUNDS(1 << 30);
#undef NEXT_JOB
#undef TR_ROUNDS
    }
    SEAM(2);

    if (IN(3)) {
        const bf16_t* o0 = (const bf16_t*)out; const bf16_t* o1 = o0 + (size_t)SEQ * 1024;
        f32x4 sg[4];
#pragma unroll
        for (int i = 0; i < 4; ++i) sg[i] = *(const f32x4*)(subln + (lane & 7) * 16 + 4 * i) * 0.8f;
        for (int row = gw; row < SEQ; row += NGW) {
            const size_t off = (size_t)row * 1024 + lane * 16;
            if (lane < 40) continue;
            f32x4 v[4]; float ss = 0.f;
#pragma unroll
            for (int i = 0; i < 2; ++i) { const u32x4 a = *(const u32x4*)(o0 + off + 8 * i), b = *(const u32x4*)(o1 + off + 8 * i);
                v[2 * i] = (f32x4){bf_lo(a.x) + bf_lo(b.x), bf_hi(a.x) + bf_hi(b.x), bf_lo(a.y) + bf_lo(b.y), bf_hi(a.y) + bf_hi(b.y)};
                v[2 * i + 1] = (f32x4){bf_lo(a.z) + bf_lo(b.z), bf_hi(a.z) + bf_hi(b.z), bf_lo(a.w) + bf_lo(b.w), bf_hi(a.w) + bf_hi(b.w)}; }
#pragma unroll
            for (int i = 0; i < 4; ++i) ss += (v[i][0] * v[i][0] + v[i][1] * v[i][1]) + (v[i][2] * v[i][2] + v[i][3] * v[i][3]);
            ss += __shfl_xor(ss, 1); ss += __shfl_xor(ss, 2); ss += __shfl_xor(ss, 4);
            const float rinv = fast_rsq(ss * (1.f / 128.f) + EPS);
#pragma unroll
            for (int i = 0; i < 4; ++i) v[i] = v[i] * rinv * sg[i];
            *(u32x4*)(OA + off) = pack8(v[0], v[1]); *(u32x4*)(OA + off + 8) = pack8(v[2], v[3]);
        }
    }


    SEAM(3);

    if (IN(4)) {
        pg8::Gemm g{OA, OB, Wbd, Wbf, 1024};
        pg8::P3Order S{G, bx};
        pg8::EpiP3 E{Gt, MGT, MG};
        pg8::gemm_phase(lds, g, S, E);
    }
    SEAM(4);

    if (IN(5)) {
        pg8::Gemm g{MG, MG, Wout, Wout, DM};
        pg8::PlainOrder S{32, 8, G, bx};
        pg8::EpiP4 E{x, (bf16_t*)(ws + WS_X1B), SS2};
        pg8::gemm_phase(lds, g, S, E);
    }
    SEAM(5);

    if (IN(6)) {
        pg8::Gemm g{(const bf16_t*)(ws + WS_X1B), (const bf16_t*)(ws + WS_X1B), Wup, Wup, DM};
        pg8::PlainOrder S{32, 32, G, bx};
        pg8::Unit u0; int pm0 = -1;
        if (S.next(0, u0)) { pm0 = u0.pm;
            LAS float* tab = (LAS float*)(lds + EPI_SCR_OFF);
            if (tid < 256) { const f32x4* sp = (const f32x4*)(SS2 + (size_t)(pm0 * 256 + tid) * 32); f32x4 sa = sp[0];
#pragma unroll
                for (int q = 1; q < 8; ++q) sa += sp[q];
                tab[tid] = fast_rsq(((sa[0] + sa[1]) + (sa[2] + sa[3])) * (1.f / DM) + EPS); }
            __syncthreads(); }
        pg8::EpiP5 E{SS2, U, pm0};
        pg8::gemm_phase(lds, g, S, E);
    }
    SEAM(6);

    if (IN(7)) {
        pg8::Gemm g{U, U, Wdown, Wdown, FF};
        pg8::PlainOrder S{32, 8, G, bx};
        pg8::EpiP6 E{(const bf16_t*)(ws + WS_X1B), out};
        pg8::gemm_phase(lds, g, S, E);
    }
#undef IN
#undef SEAM
}

#ifdef PROBE_PHASE
__global__ void dump_bf16(const bf16_t* a, const bf16_t* b, float* dst, size_t nhalf) {
    for (size_t i = blockIdx.x * (size_t)blockDim.x + threadIdx.x; i < nhalf; i += (size_t)gridDim.x * blockDim.x) { dst[i] = bf_lo((unsigned)a[i]); dst[nhalf + i] = bf_lo((unsigned)b[i]); }
}
#endif
extern "C" void kernel_launch(void* const* d_in, const int* in_sizes, int n_in, void* d_out, int out_size, void* d_ws, size_t ws_size, hipStream_t stream) {
    static int grid = 0;
    if (grid == 0) {
        if (n_in != 21 || out_size != SEQ * DM || ws_size < WS_END) { fprintf(stderr, "kernel_launch: unexpected problem (n_in %d, out %d, ws %zu)\n", n_in, out_size, ws_size); grid = -1; return; }
        int dev = 0, cus = 0, per_cu = 0;
        hipGetDevice(&dev);
        hipDeviceGetAttribute(&cus, hipDeviceAttributeMultiprocessorCount, dev);
        hipFuncSetAttribute((const void*)fwd_kernel, hipFuncAttributeMaxDynamicSharedMemorySize, LDS_BYTES);
        hipOccupancyMaxActiveBlocksPerMultiprocessor(&per_cu, (const void*)fwd_kernel, NTHREADS, LDS_BYTES);
        if (per_cu < 1) { fprintf(stderr, "kernel_launch: occupancy query says %d blocks per CU\n", per_cu); per_cu = 1; }
        if (per_cu > 1) per_cu = 1;
        grid = cus * per_cu;
        (void)hipGetLastError();
    }
    if (grid < 0) return;
    (void)hipMemsetAsync((char*)d_ws + WS_CTL, 0, CTL_BYTES, stream);
    Args a{};
    for (int i = 0; i < 21; ++i) a.in[i] = (const float*)d_in[i];
    a.out = (float*)d_out; a.ws = (unsigned char*)d_ws;
#if REPEAT_PHASE >= 0
    for (int p = 0; p < 8; ++p) { a.ph_lo = p; a.ph_hi = p + 1; a.att_sel = 0; hipLaunchKernelGGL(fwd_kernel, dim3(grid), dim3(NTHREADS), LDS_BYTES, stream, a);
        if ((REPEAT_PHASE >> p) & 1) { a.att_sel = REPEAT_PHASE >> 8; (void)hipMemsetAsync((char*)d_ws + WS_CTL, 0, 64, stream); hipLaunchKernelGGL(fwd_kernel, dim3(grid), dim3(NTHREADS), LDS_BYTES, stream, a); } }
#elif MK_N_LAUNCHES == 1
    a.ph_lo = 0; a.ph_hi = 8;
    void* kargs[] = {&a};
    hipError_t e = hipLaunchCooperativeKernel((const void*)fwd_kernel, dim3(grid), dim3(NTHREADS), kargs, LDS_BYTES, stream);
    if (e != hipSuccess) fprintf(stderr, "cooperative launch failed: %s (grid %d)\n", hipGetErrorString(e), grid);
#else
#ifdef PROBE_PHASE
    for (int p = 0; p <= PROBE_PHASE; ++p) { a.ph_lo = p; a.ph_hi = p + 1; hipLaunchKernelGGL(fwd_kernel, dim3(grid), dim3(NTHREADS), LDS_BYTES, stream, a); }
    { const unsigned char* w = (const unsigned char*)d_ws; hipLaunchKernelGGL(dump_bf16, dim3(2048), dim3(256), 0, stream, (const bf16_t*)(w + PROBE_A), (const bf16_t*)(w + PROBE_B), (float*)d_out, (size_t)SEQ * 1024); }
#else
    for (int p = 0; p < 8; ++p) { a.ph_lo = p; a.ph_hi = p + 1; hipLaunchKernelGGL(fwd_kernel, dim3(grid), dim3(NTHREADS), LDS_BYTES, stream, a); }
#endif
#endif
}
```

```cpp
#include <hip/hip_runtime.h>
#include <hip/hip_cooperative_groups.h>
#include <cstdio>
#include <cstdint>
namespace cg = cooperative_groups;

#ifndef REPEAT_PHASE
#define REPEAT_PHASE -1
#endif
#ifndef MK_N_LAUNCHES
#define MK_N_LAUNCHES 1
#endif

#define LAS __attribute__((address_space(3)))
typedef unsigned short bf16_t;
typedef short bf16x8 __attribute__((ext_vector_type(8)));
typedef float f32x4 __attribute__((ext_vector_type(4)));
typedef float f32x16 __attribute__((ext_vector_type(16)));
typedef unsigned u32x4 __attribute__((ext_vector_type(4)));
typedef unsigned u32x2 __attribute__((ext_vector_type(2)));

constexpr int SEQ = 8192, DM = 2048, NPROJ = 6152, FF = 8192;
constexpr float EPS = 1e-6f, LOG2E = 1.4426950408889634f;
constexpr int NTHREADS = 512, NWAVES = 8;

constexpr size_t MiB = 1u << 20;
constexpr size_t WS_LF = 0;
constexpr size_t WS_C2 = 256 * 1024;
constexpr size_t WS_GN = 512 * 1024;
constexpr size_t WS_CTL = 768 * 1024;
constexpr size_t CTL_BYTES = 32768;
constexpr size_t WS_SS2 = 1 * MiB;
constexpr size_t WS_WBD = 8 * MiB, WS_WBF = 12 * MiB, WS_WOUT = 16 * MiB;
constexpr size_t WS_WT1 = 24 * MiB, WS_WUP = 24 * MiB;
constexpr size_t WS_WT2 = 56 * MiB;
constexpr size_t WS_H = 64 * MiB, WS_WDOWN = 64 * MiB;
constexpr size_t WS_QA = 96 * MiB, WS_KA = 112 * MiB, WS_QB = 128 * MiB, WS_KB = 144 * MiB;
constexpr size_t WS_MGT = 96 * MiB;
constexpr size_t WS_VT = 160 * MiB, WS_MG = 160 * MiB;
constexpr size_t WS_G = 192 * MiB;
constexpr size_t WS_OA = 256 * MiB, WS_OB = 272 * MiB, WS_XG = 256 * MiB;
constexpr size_t WS_X1B = 224 * MiB;
constexpr size_t WS_U = 96 * MiB;
constexpr size_t WS_END = 288 * MiB;

constexpr int GEMM_LDS = 131072;
constexpr int EPI_SCR_OFF = GEMM_LDS;
constexpr int LDS_BYTES = GEMM_LDS + 4096 + 1024;
constexpr int LDS_BAR_OFF = LDS_BYTES - 16;
constexpr int P0_SCR_STRIDE = 8704, P0_WF_OFF = 8 * P0_SCR_STRIDE;
static_assert(P0_WF_OFF + 65536 <= LDS_BAR_OFF, "P0 LDS map");

typedef float f32x2_t __attribute__((ext_vector_type(2)));
typedef __bf16 bf16x2_t __attribute__((ext_vector_type(2)));
__device__ __forceinline__ unsigned cvt_pk_bf16(float lo, float hi) { const f32x2_t v = {lo, hi}; const bf16x2_t b = __builtin_convertvector(v, bf16x2_t); return __builtin_bit_cast(unsigned, b); }
__device__ __forceinline__ u32x4 pack8(const f32x4& a, const f32x4& b) { u32x4 w; w.x = cvt_pk_bf16(a[0], a[1]); w.y = cvt_pk_bf16(a[2], a[3]); w.z = cvt_pk_bf16(b[0], b[1]); w.w = cvt_pk_bf16(b[2], b[3]); return w; }
__device__ __forceinline__ float bf_lo(unsigned u) { return __uint_as_float(u << 16); }
__device__ __forceinline__ float bf_hi(unsigned u) { return __uint_as_float(u & 0xffff0000u); }
__device__ __forceinline__ float fast_exp2(float x) { return __builtin_amdgcn_exp2f(x); }
__device__ __forceinline__ float fast_rcp(float x) { return __builtin_amdgcn_rcpf(x); }
__device__ __forceinline__ float fast_rsq(float x) { return __builtin_amdgcn_rsqf(x); }
__device__ __forceinline__ float wave_sum(float v) {
#pragma unroll
    for (int o = 1; o < 64; o <<= 1) v += __shfl_xor(v, o);
    return v;
}
#define LDS_WAIT() asm volatile("s_waitcnt lgkmcnt(0)" ::: "memory")

namespace pg8 {
constexpr int BM = 256, BK = 64, HALF = 128, HTB = HALF * BK * 2, STAGE_BYTES = 8 * HTB, NXCD = 8, WGM = 4;
__host__ __device__ __forceinline__ int lds_byte(int r, int c) { const int st = (r >> 4) * 2 + (c >> 5), rr = r & 15, cc = c & 31, ob = rr * 64 + cc * 2; return st * 1024 + (ob ^ (((ob >> 9) & 1) << 5)); }
__host__ __device__ __forceinline__ void stage_rc(int b, int& R, int& C) { const int st = b / 1024, sb = b % 1024, swz = sb ^ (((sb >> 9) & 1) << 5); R = (st >> 1) * 16 + swz / 64; C = (st & 1) * 32 + (swz % 64) / 2; }
__host__ __device__ __forceinline__ int perm32(int rho) { const int n = rho >> 4, i = rho & 15; return 8 * (i >> 2) + 4 * n + (i & 3); }

struct Unit { int pm, pn, sel; };
struct Gemm { const bf16_t *A0, *A1, *B0, *B1; int K; };

__host__ __device__ __forceinline__ void map_tile(int L, int nM, int nN, Unit& u) {
    const int nwg = nM * nN; int wgid = L;
    { const int q = nwg / NXCD, r = nwg % NXCD, xcd = wgid % NXCD, off = wgid / NXCD; wgid = (xcd < r ? xcd * (q + 1) : r * (q + 1) + (xcd - r) * q) + off; }
    const int nig = WGM * nN, gid = wgid / nig, fm = gid * WGM, gsz = (nM - fm) < WGM ? (nM - fm) : WGM;
    u.pm = fm + ((wgid % nig) % gsz); u.pn = (wgid % nig) / gsz;
}
struct PlainOrder { int nM, nN, G, c;
    __device__ __forceinline__ bool next(int i, Unit& u) const { const long L = (long)i * G + c; if (L >= (long)nM * nN) return false; map_tile((int)L, nM, nN, u); u.sel = 0; return true; } };
struct P1Order { int G, c;
    __device__ __forceinline__ bool next(int i, Unit& u) const { long L = (long)i * G + c; if (L < 1024) { map_tile((int)L, 32, 32, u); u.sel = 0; return true; } L -= 1024; if (L < 256) { map_tile((int)L, 8, 32, u); u.sel = 1; return true; } return false; } };
struct P3Order { int G, c;
    __device__ __forceinline__ bool next(int i, Unit& u) const { const long L = (long)(i >> 1) * G + c; if (L >= 256) return false; map_tile((int)L, 32, 8, u); u.sel = i & 1; return true; } };

template <class Epi, class Sched>
__device__ __forceinline__ void gemm_phase(LAS unsigned char* lds, const Gemm g, const Sched& S, const Epi& E) {
    const int tid = threadIdx.x, wid = __builtin_amdgcn_readfirstlane(tid >> 6), lane = tid & 63, wr = wid >> 2, wc = wid & 3, fr = lane & 15, fq = lane >> 4;
    const int K = g.K, nt = K / BK;
    unsigned voffA[2], voffB[2];
#pragma unroll
    for (int i = 0; i < 2; ++i) { int R, C; stage_rc(tid * 16 + i * 8192, R, C); const int Rb = 64 * (R >> 5) + perm32(R & 31);
        voffA[i] = (unsigned)(R * K + C) * 2u; voffB[i] = (unsigned)(Rb * K + C) * 2u; }
    const size_t kstep = (size_t)(BK * 2);
    const size_t hstep = (size_t)HALF * K * 2;
    const size_t hstepB = (size_t)32 * K * 2;
    const size_t tstep = 2 * hstep;
    const unsigned ldsw = (unsigned)wid * 1024u;
    const int aoff = lds_byte(wr * 64 + fr, fq * 8), boff = lds_byte(wc * 32 + fr, fq * 8);
#define PG8_SA(b, h) (((b) * 2 + (h)) * HTB)
#define PG8_SB(b, h) ((4 + (b) * 2 + (h)) * HTB)
#define PG8_STAGE(bufoff, gbase, voff) do { _Pragma("unroll") for (int _i = 0; _i < 2; ++_i) \
        __builtin_amdgcn_global_load_lds((const unsigned*)((const char*)(gbase) + (voff)[_i]), (LAS unsigned*)(lds + (bufoff) + ldsw + _i * 8192), 16, 0, 0); } while (0)
#define PG8_LDA(dst, b, h) do { _Pragma("unroll") for (int m = 0; m < 4; ++m) _Pragma("unroll") for (int k = 0; k < 2; ++k) dst[m][k] = *(const LAS bf16x8*)(lds + PG8_SA(b, h) + aoff + m * 2048 + k * 1024); } while (0)
#define PG8_LDB(dst, b, h) do { _Pragma("unroll") for (int n = 0; n < 2; ++n) _Pragma("unroll") for (int k = 0; k < 2; ++k) dst[n][k] = *(const LAS bf16x8*)(lds + PG8_SB(b, h) + boff + n * 2048 + k * 1024); } while (0)
#define PG8_MMA(ai, bj, At, Bt) do { __builtin_amdgcn_s_setprio(1); _Pragma("unroll") for (int m = 0; m < 4; ++m) _Pragma("unroll") for (int n = 0; n < 2; ++n) _Pragma("unroll") for (int k = 0; k < 2; ++k) \
        acc[ai][bj][m][n] = __builtin_amdgcn_mfma_f32_16x16x32_bf16(Bt[n][k], At[m][k], acc[ai][bj][m][n], 0, 0, 0); __builtin_amdgcn_s_setprio(0); } while (0)
#define PG8_WAIT_V(n) asm volatile("s_waitcnt vmcnt(" #n ")" ::: "memory")
#define PG8_WAIT_L(n) asm volatile("s_waitcnt lgkmcnt(" #n ")" ::: "memory")
#define PG8_BAR __builtin_amdgcn_s_barrier()
#define PG8_SCHED __builtin_amdgcn_sched_barrier(0)
    Unit cur, nxt; int ui = 0;
    if (!S.next(0, cur)) return;
    f32x4 acc[2][2][4][2];
#pragma unroll
    for (int a = 0; a < 2; ++a)
#pragma unroll
        for (int b = 0; b < 2; ++b)
#pragma unroll
            for (int m = 0; m < 4; ++m)
#pragma unroll
                for (int n = 0; n < 2; ++n) acc[a][b][m][n] = (f32x4){0.f, 0.f, 0.f, 0.f};
    bf16x8 At[4][2], B0[2][2], B1[2][2];
    const char* cA = (const char*)(cur.sel ? g.A1 : g.A0) + (size_t)cur.pm * tstep; const char* cB = (const char*)(cur.sel ? g.B1 : g.B0) + (size_t)cur.pn * tstep;
    PG8_STAGE(PG8_SB(0, 0), cB, voffB); PG8_STAGE(PG8_SB(0, 1), cB + hstepB, voffB); PG8_STAGE(PG8_SA(0, 0), cA, voffA); PG8_STAGE(PG8_SA(0, 1), cA + hstep, voffA);
    if (wr == 1) PG8_BAR;
    PG8_WAIT_V(2); PG8_BAR;
    PG8_STAGE(PG8_SB(1, 0), cB + kstep, voffB); PG8_STAGE(PG8_SA(1, 0), cA + kstep, voffA); PG8_STAGE(PG8_SB(1, 1), cB + hstepB + kstep, voffB);
    PG8_WAIT_V(6); PG8_BAR;
    for (;;) {
        const bool has_next = S.next(ui + 1, nxt);
        const char* nA = has_next ? (const char*)(nxt.sel ? g.A1 : g.A0) + (size_t)nxt.pm * tstep : cA; const char* nB = has_next ? (const char*)(nxt.sel ? g.B1 : g.B0) + (size_t)nxt.pn * tstep : cB;
        for (int t = 0; t < nt; t += 2) {
            const bool last = (t == nt - 2);
            const char* a1 = cA + (size_t)(t + 1) * kstep;
            const char* a2 = last ? nA : cA + (size_t)(t + 2) * kstep; const char* b2 = last ? nB : cB + (size_t)(t + 2) * kstep;
            const char* a3 = a2 + kstep; const char* b3 = b2 + kstep;
            PG8_LDB(B0, 0, 0); PG8_LDB(B1, 0, 1); PG8_SCHED; PG8_LDA(At, 0, 0); PG8_STAGE(PG8_SA(1, 1), a1 + hstep, voffA);
            PG8_WAIT_V(8); PG8_WAIT_L(0); PG8_BAR; PG8_MMA(0, 0, At, B0); PG8_MMA(0, 1, At, B1); PG8_BAR; PG8_SCHED;
            PG8_LDA(At, 0, 1); PG8_STAGE(PG8_SB(0, 0), b2, voffB); PG8_STAGE(PG8_SB(0, 1), b2 + hstepB, voffB); PG8_STAGE(PG8_SA(0, 0), a2, voffA);
            PG8_WAIT_V(8); PG8_WAIT_L(0); PG8_BAR; PG8_MMA(1, 0, At, B0); PG8_MMA(1, 1, At, B1); PG8_BAR; PG8_SCHED;
            PG8_LDB(B0, 1, 0); PG8_LDB(B1, 1, 1); PG8_SCHED; PG8_LDA(At, 1, 0); PG8_STAGE(PG8_SA(0, 1), a2 + hstep, voffA);
            PG8_WAIT_V(8); PG8_WAIT_L(0); PG8_BAR; PG8_MMA(0, 0, At, B0); PG8_MMA(0, 1, At, B1); PG8_BAR; PG8_SCHED;
            PG8_LDA(At, 1, 1); PG8_STAGE(PG8_SB(1, 0), b3, voffB); PG8_STAGE(PG8_SB(1, 1), b3 + hstepB, voffB); PG8_STAGE(PG8_SA(1, 0), a3, voffA);
            PG8_WAIT_V(8); PG8_WAIT_L(0); PG8_BAR; PG8_MMA(1, 0, At, B0); PG8_MMA(1, 1, At, B1); PG8_BAR; PG8_SCHED;
        }
        if (wr == 0) PG8_BAR;
        E(acc, cur, wr, wc, fr, fq, (LAS float*)(lds + EPI_SCR_OFF));
        if (!has_next) break;
#pragma unroll
        for (int a = 0; a < 2; ++a)
#pragma unroll
            for (int b = 0; b < 2; ++b)
#pragma unroll
                for (int m = 0; m < 4; ++m)
#pragma unroll
                    for (int n = 0; n < 2; ++n) acc[a][b][m][n] = (f32x4){0.f, 0.f, 0.f, 0.f};
        cur = nxt; cA = nA; cB = nB; ++ui;
        if (wr == 1) PG8_BAR;
    }
    PG8_WAIT_V(0);
    PG8_BAR;
#undef PG8_SA
#undef PG8_SB
#undef PG8_STAGE
#undef PG8_LDA
#undef PG8_LDB
#undef PG8_MMA
#undef PG8_WAIT_V
#undef PG8_WAIT_L
#undef PG8_BAR
#undef PG8_SCHED
}

typedef f32x4 Acc[2][2][4][2];

struct EpiP1 {
    bf16_t *QA, *G, *VT; const float *GN, *bgate;
    __device__ __forceinline__ void operator()(Acc& acc, const Unit& u, int wr, int wc, int fr, int fq, LAS float* scr) const {
        const int colw = 64 * wc + 8 * fq, rowl = wr * 64 + fr;
        if (u.sel == 1) {
            const int tok0 = u.pn * BM + colw;
#pragma unroll
            for (int ai = 0; ai < 2; ++ai)
#pragma unroll
                for (int m = 0; m < 4; ++m) { const int vd = u.pm * BM + rowl + ai * HALF + m * 16;
#pragma unroll
                    for (int bj = 0; bj < 2; ++bj) { const int tok = tok0 + 32 * bj;
                        *(u32x4*)(VT + ((size_t)((vd >> 7) * 128 + (tok >> 6)) * 8192 + (vd & 127) * 64 + (tok & 63))) = pack8(acc[ai][bj][m][0], acc[ai][bj][m][1]); } }
            return;
        }
        if (u.pn >= 16) {
            const int gcol = (u.pn - 16) * BM + colw;
            f32x4 bv[2][2];
#pragma unroll
            for (int bj = 0; bj < 2; ++bj)
#pragma unroll
                for (int n = 0; n < 2; ++n) bv[bj][n] = *(const f32x4*)(bgate + gcol + 32 * bj + 4 * n);
            bf16_t* base = G + (size_t)(u.pm * BM + rowl) * 4096 + gcol;
#pragma unroll
            for (int ai = 0; ai < 2; ++ai)
#pragma unroll
                for (int m = 0; m < 4; ++m) { bf16_t* rp = base + (size_t)(ai * HALF + m * 16) * 4096;
#pragma unroll
                    for (int bj = 0; bj < 2; ++bj) { f32x4 v[2];
#pragma unroll
                        for (int n = 0; n < 2; ++n)
#pragma unroll
                            for (int j = 0; j < 4; ++j) { const float z = acc[ai][bj][m][n][j] + bv[bj][n][j]; v[n][j] = fast_rcp(1.f + fast_exp2(-z * LOG2E)); }
                        *(u32x4*)(rp + 32 * bj) = pack8(v[0], v[1]); } }
            return;
        }
        const int t = u.pn >> 2; const bool fox = t >= 2;
        bf16_t* O = QA + (size_t)t * (8u << 20);
        const float* gn = GN + t * 128;
        const int d0 = (fox ? 64 * (wc & 1) : 0) + 8 * fq;
        f32x4 gv[2][2];
#pragma unroll
        for (int bj = 0; bj < 2; ++bj)
#pragma unroll
            for (int n = 0; n < 2; ++n) gv[bj][n] = *(const f32x4*)(gn + d0 + 32 * bj + 4 * n);
        float ss[2][4];
#pragma unroll
        for (int ai = 0; ai < 2; ++ai)
#pragma unroll
            for (int m = 0; m < 4; ++m) { float s = 0.f;
#pragma unroll
                for (int bj = 0; bj < 2; ++bj)
#pragma unroll
                    for (int n = 0; n < 2; ++n) { const f32x4 x = acc[ai][bj][m][n]; s += (x[0] * x[0] + x[1] * x[1]) + (x[2] * x[2] + x[3] * x[3]); }
                s += __shfl_xor(s, 16); s += __shfl_xor(s, 32); ss[ai][m] = s; }
        if (fox) {
            if (fq == 0) {
#pragma unroll
                for (int ai = 0; ai < 2; ++ai)
#pragma unroll
                    for (int m = 0; m < 4; ++m) scr[(ai * HALF + rowl + m * 16) * 4 + wc] = ss[ai][m];
            }
            LDS_WAIT(); __builtin_amdgcn_s_barrier(); asm volatile("" ::: "memory");
#pragma unroll
            for (int ai = 0; ai < 2; ++ai)
#pragma unroll
                for (int m = 0; m < 4; ++m) ss[ai][m] += scr[(ai * HALF + rowl + m * 16) * 4 + (wc ^ 1)];
            LDS_WAIT();
        }
        const float inv = fox ? (1.f / 128.f) : (1.f / 64.f);
        const bool isk = (t & 1) != 0; const int wsh = fox ? 7 : 6;
#pragma unroll
        for (int ai = 0; ai < 2; ++ai)
#pragma unroll
            for (int m = 0; m < 4; ++m) { const float rinv = fast_rsq(ss[ai][m] * inv + EPS); const int tok = u.pm * BM + rowl + ai * HALF + m * 16;
#pragma unroll
                for (int bj = 0; bj < 2; ++bj) { const f32x4 v0 = acc[ai][bj][m][0] * rinv * gv[bj][0], v1 = acc[ai][bj][m][1] * rinv * gv[bj][1];
                    const int col = (u.pn & 3) * BM + colw + 32 * bj;
                    const size_t off = isk ? ((size_t)((col >> wsh) * 128 + (tok >> 6)) << (6 + wsh)) + ((tok & 63) << wsh) + (col & ((1 << wsh) - 1)) : (size_t)tok * 1024 + col;
                    *(u32x4*)(O + off) = pack8(v0, v1); } }
    }
};

struct EpiP3 {
    const bf16_t* G; bf16_t* MGT; bf16_t* MG;
    __device__ __forceinline__ void operator()(Acc& acc, const Unit& u, int wr, int wc, int fr, int fq, LAS float*) const {
        const int col = u.pn * BM + 64 * wc + 8 * fq, row0 = u.pm * BM + wr * 64 + fr;
#pragma unroll
        for (int ai = 0; ai < 2; ++ai)
#pragma unroll
            for (int m = 0; m < 4; ++m) { const size_t row = (size_t)(row0 + ai * HALF + m * 16);
#pragma unroll
                for (int bj = 0; bj < 2; ++bj) { const int c = col + 32 * bj;
                    const u32x4 gw = *(const u32x4*)(G + row * 4096 + (u.sel ? 2048 : 0) + c);
                    const f32x4 g0 = {bf_lo(gw.x), bf_hi(gw.x), bf_lo(gw.y), bf_hi(gw.y)}, g1 = {bf_lo(gw.z), bf_hi(gw.z), bf_lo(gw.w), bf_hi(gw.w)};
                    f32x4 v0 = acc[ai][bj][m][0] * g0, v1 = acc[ai][bj][m][1] * g1;
                    bf16_t* tp = MGT + row * DM + c;
                    if (u.sel == 0) { *(u32x4*)tp = pack8(v0, v1); }
                    else { const u32x4 tw = *(const u32x4*)tp;
                        v0 += (f32x4){bf_lo(tw.x), bf_hi(tw.x), bf_lo(tw.y), bf_hi(tw.y)}; v1 += (f32x4){bf_lo(tw.z), bf_hi(tw.z), bf_lo(tw.w), bf_hi(tw.w)};
                        *(u32x4*)(MG + row * DM + c) = pack8(v0, v1); } } }
    }
};

struct EpiP4 {
    const float* x; bf16_t* X1B; float* SS2;
    __device__ __forceinline__ void operator()(Acc& acc, const Unit& u, int wr, int wc, int fr, int fq, LAS float*) const {
        const int col = u.pn * BM + 64 * wc + 8 * fq, row0 = u.pm * BM + wr * 64 + fr;
#pragma unroll
        for (int ai = 0; ai < 2; ++ai)
#pragma unroll
            for (int m = 0; m < 4; ++m) { const size_t row = (size_t)(row0 + ai * HALF + m * 16); float s = 0.f;
#pragma unroll
                for (int bj = 0; bj < 2; ++bj) { const size_t o = row * DM + col + 32 * bj;
                    const f32x4 v0 = acc[ai][bj][m][0] + *(const f32x4*)(x + o), v1 = acc[ai][bj][m][1] + *(const f32x4*)(x + o + 4);
                    *(u32x4*)(X1B + o) = pack8(v0, v1);
                    s += (v0[0] * v0[0] + v0[1] * v0[1]) + (v0[2] * v0[2] + v0[3] * v0[3]) + (v1[0] * v1[0] + v1[1] * v1[1]) + (v1[2] * v1[2] + v1[3] * v1[3]); }
                s += __shfl_xor(s, 16); s += __shfl_xor(s, 32);
                if (fq == 0) SS2[row * 32 + u.pn * 4 + wc] = s; }
    }
};

struct EpiP5 {
    const float* SS2; bf16_t* U; int pm0;
    __device__ __forceinline__ void operator()(Acc& acc, const Unit& u, int wr, int wc, int fr, int fq, LAS float* scr) const {
        const int col = u.pn * BM + 64 * wc + 8 * fq, row0 = u.pm * BM + wr * 64 + fr;
#pragma unroll
        for (int ai = 0; ai < 2; ++ai)
#pragma unroll
            for (int m = 0; m < 4; ++m) { const size_t row = (size_t)(row0 + ai * HALF + m * 16);
                float rinv;
                if (u.pm == pm0) rinv = scr[wr * 64 + fr + ai * HALF + m * 16];
                else { const f32x4* sp = (const f32x4*)(SS2 + row * 32); f32x4 sa = sp[0];
#pragma unroll
                    for (int q = 1; q < 8; ++q) sa += sp[q];
                    rinv = fast_rsq(((sa[0] + sa[1]) + (sa[2] + sa[3])) * (1.f / DM) + EPS); }
#pragma unroll
                for (int bj = 0; bj < 2; ++bj) { f32x4 v[2];
#pragma unroll
                    for (int n = 0; n < 2; ++n)
#pragma unroll
                        for (int j = 0; j < 4; ++j) { const float z = fmaxf(acc[ai][bj][m][n][j] * rinv, 0.f); v[n][j] = z * z; }
                    *(u32x4*)(U + row * FF + col + 32 * bj) = pack8(v[0], v[1]); } }
    }
};

struct EpiP6 {
    const bf16_t* X1B; float* out;
    __device__ __forceinline__ void operator()(Acc& acc, const Unit& u, int wr, int wc, int fr, int fq, LAS float*) const {
        const int col = u.pn * BM + 64 * wc + 8 * fq, row0 = u.pm * BM + wr * 64 + fr;
#pragma unroll
        for (int ai = 0; ai < 2; ++ai)
#pragma unroll
            for (int m = 0; m < 4; ++m) { const size_t row = (size_t)(row0 + ai * HALF + m * 16);
#pragma unroll
                for (int bj = 0; bj < 2; ++bj) { const size_t o = row * DM + col + 32 * bj; const u32x4 xw = *(const u32x4*)(X1B + o);
                    const f32x4 v0 = acc[ai][bj][m][0] + (f32x4){bf_lo(xw.x), bf_hi(xw.x), bf_lo(xw.y), bf_hi(xw.y)}, v1 = acc[ai][bj][m][1] + (f32x4){bf_lo(xw.z), bf_hi(xw.z), bf_lo(xw.w), bf_hi(xw.w)};
                    *(f32x4*)(out + o) = v0; *(f32x4*)(out + o + 4) = v1; } }
    }
};
}

__device__ __forceinline__ void transpose_item(const float* __restrict__ W, int ld, int col0, int ncols, int K, bf16_t* WT, int row_off, LAS float* scr, int item, int lane) {
    const int nblk = ncols / 32, kb = item / nblk, nb = item % nblk, k0 = 64 * kb, n0 = 32 * nb;
    const float* wp = W + (size_t)(k0 + (lane >> 5)) * ld + col0 + n0 + (lane & 31);
    LAS float* sp = scr + (lane >> 5) * 33 + (lane & 31);
#pragma unroll 4
    for (int i = 0; i < 32; ++i) { sp[i * 66] = *wp; wp += 2 * ld; }
    LDS_WAIT();
    const int c = lane & 7;
#pragma unroll
    for (int j = 0; j < 4; ++j) { const int n = (lane >> 3) + 8 * j; const LAS float* s = scr + (8 * c) * 33 + n;
        u32x4 o; o.x = cvt_pk_bf16(s[0 * 33], s[1 * 33]); o.y = cvt_pk_bf16(s[2 * 33], s[3 * 33]); o.z = cvt_pk_bf16(s[4 * 33], s[5 * 33]); o.w = cvt_pk_bf16(s[6 * 33], s[7 * 33]);
        *(u32x4*)(WT + (size_t)(row_off + n0 + n) * K + k0 + 8 * c) = o; }
    LDS_WAIT();
}

__device__ __forceinline__ void transpose_item64(const float* __restrict__ W, int ld, int ncols, int K, bf16_t* WT, LAS float* scr, int item, int lane, const float* ks = nullptr) {
    const int nblk = ncols / 64, kb = item / nblk, nb = item % nblk, k0 = 64 * kb, n0 = 64 * nb;
    const float* wp = W + (size_t)(k0 + (lane >> 4)) * ld + n0 + 4 * (lane & 15);
    f32x4 v[16];
#pragma unroll
    for (int i = 0; i < 16; ++i) v[i] = *(const f32x4*)(wp + (size_t)(4 * i) * ld);
    if (ks) {
#pragma unroll
        for (int i = 0; i < 16; ++i) v[i] = v[i] * ks[k0 + 4 * i + (lane >> 4)]; }
    LAS float* sp = scr + (lane >> 4) * 65 + 4 * (lane & 15);
#pragma unroll
    for (int i = 0; i < 16; ++i) { sp[(4 * i) * 65 + 0] = v[i][0]; sp[(4 * i) * 65 + 1] = v[i][1]; sp[(4 * i) * 65 + 2] = v[i][2]; sp[(4 * i) * 65 + 3] = v[i][3]; }
    LDS_WAIT();
    const int c = lane >> 3;
#pragma unroll
    for (int j = 0; j < 8; ++j) { const int n = (lane & 7) + 8 * j; const LAS float* s = scr + (8 * c) * 65 + n;
        u32x4 o; o.x = cvt_pk_bf16(s[0 * 65], s[1 * 65]); o.y = cvt_pk_bf16(s[2 * 65], s[3 * 65]); o.z = cvt_pk_bf16(s[4 * 65], s[5 * 65]); o.w = cvt_pk_bf16(s[6 * 65], s[7 * 65]);
        *(u32x4*)(WT + (size_t)(n0 + n) * K + k0 + 8 * c) = o; }
    LDS_WAIT();
}

namespace att {
constexpr int VROW = 144, BUF = 36864;
static_assert(2 * BUF <= GEMM_LDS, "attention LDS map");
#define MFMA32(a, b, c) __builtin_amdgcn_mfma_f32_32x32x16_bf16((a), (b), (c), 0, 0, 0)

__device__ __forceinline__ void pack_p(const f32x16& S, bf16x8 (&pf)[2]) {
#pragma unroll
    for (int s = 0; s < 2; ++s) { u32x4 p; p.x = cvt_pk_bf16(S[8 * s + 0], S[8 * s + 1]); p.y = cvt_pk_bf16(S[8 * s + 2], S[8 * s + 3]); p.z = cvt_pk_bf16(S[8 * s + 4], S[8 * s + 5]); p.w = cvt_pk_bf16(S[8 * s + 6], S[8 * s + 7]);
        pf[s] = __builtin_bit_cast(bf16x8, p); }
}
constexpr float PRUNE_THR = 80.f;
template <bool DIFF>
__device__ __forceinline__ void attn_unit(LAS unsigned char* lds, const bf16_t* __restrict__ Q, const bf16_t* __restrict__ Kg, const bf16_t* __restrict__ Vt, const float* __restrict__ c2g,
                                          bf16_t* Og, float* park, int head, int qb, int mp, float lam, const float* GN, const bool both = false, bf16_t* OAf = nullptr, const float* subln = nullptr) {
    constexpr int NX = DIFF ? 4 : 8, KROW = DIFF ? 144 : 272, V_OFF = 64 * KROW, C2_OFF = V_OFF + 128 * VROW;
    static_assert(C2_OFF + 256 <= BUF, "attention buffer");
    const int tid = threadIdx.x, lane = tid & 63, w = __builtin_amdgcn_readfirstlane(tid >> 6), r = lane & 31, h = lane >> 5;
    const int trow = qb * 256 + 32 * w + r;
    const int jmax = 4 * qb + 3, jd = 4 * qb + (w >> 1);
    const int toff = 32 * (w & 1) + r;
    const float slope2 = DIFF ? exp2f(-(float)(head + 1)) * LOG2E : 0.f;
    const bf16_t* gV = Vt + (size_t)head * 128 * 8192 + tid * 8;
    const unsigned lV = V_OFF + (tid >> 3) * VROW + (tid & 7) * 16;
    const unsigned lK = DIFF ? (tid >> 3) * KROW + (tid & 7) * 16 : (tid >> 4) * KROW + (tid & 15) * 16;
    const int kap = (r & ~12) | ((r & 4) << 1) | ((r & 8) >> 1);
    const unsigned rK = kap * KROW + 16 * h, rV = V_OFF + r * VROW + 16 * h;
    f32x16 O[4];
    int jmin = 0;
    if (DIFF) {
        float gq = fabsf(GN[lane]), gk = fabsf(GN[128 + lane]);
#pragma unroll
        for (int o = 1; o < 64; o <<= 1) { gq = fmaxf(gq, __shfl_xor(gq, o)); gk = fmaxf(gk, __shfl_xor(gk, o)); }
        const float B2 = 2.f * 1.05f * 64.f * gq * gk;
        const float dmax = (PRUNE_THR + B2) / slope2;
        const float jf = ceilf(((float)(256 * qb - 63) - dmax) * (1.f / 64.f));
        jmin = jf > 0.f ? (int)jf : 0;
    } else {
        float gq = fmaxf(fabsf(GN[256 + lane]), fabsf(GN[320 + lane])), gk = fmaxf(fabsf(GN[384 + lane]), fabsf(GN[448 + lane]));
#pragma unroll
        for (int o = 1; o < 64; o <<= 1) { gq = fmaxf(gq, __shfl_xor(gq, o)); gk = fmaxf(gk, __shfl_xor(gk, o)); }
        const float B2 = 2.f * 1.05f * 128.f * gq * gk;
        const float cref = c2g[head * SEQ + 256 * qb];
        const int j0 = lane, j1 = lane + 64;
        const bool n0 = (j0 <= jmax) && (B2 + c2g[head * SEQ + 64 * (j0 <= jmax ? j0 : 0) + 63] - cref >= -PRUNE_THR);
        const bool n1 = (j1 <= jmax) && (B2 + c2g[head * SEQ + 64 * (j1 <= jmax ? j1 : 0) + 63] - cref >= -PRUNE_THR);
        const unsigned long long b0 = __ballot(n0), b1 = __ballot(n1);
        jmin = b0 ? (__ffsll((long long)b0) - 1) : (b1 ? 64 + __ffsll((long long)b1) - 1 : 4 * qb);
        if (jmin > 4 * qb) jmin = 4 * qb;
    }
    jmin = __builtin_amdgcn_readfirstlane(jmin);
#pragma unroll 1
    for (int pass = 0; pass < (DIFF && both ? 2 : 1); ++pass) {
        const int mpc = (DIFF && both) ? pass : mp;
        bf16x8 qf[NX];
        { const bf16_t* qp = Q + (size_t)trow * 1024 + head * 128 + (DIFF ? 64 * mpc : 0) + 8 * h;
#pragma unroll
          for (int x = 0; x < NX; ++x) qf[x] = *(const bf16x8*)(qp + 16 * x);
#pragma unroll
          for (int x = 0; x < NX; ++x) asm volatile("" : "+v"(qf[x])); }
        const bf16_t* gK = DIFF ? Kg + (size_t)(head * 2 + mpc) * 128 * 4096 + tid * 8 : Kg + (size_t)head * 128 * 8192 + tid * 8;
        u32x4 kreg[2], vreg[2]; float creg = 0.f;
#define ATT_LOAD(j) do { const size_t j_ = (size_t)(j); kreg[0] = *(const u32x4*)(gK + j_ * (DIFF ? 4096 : 8192)); if (!DIFF) kreg[1] = *(const u32x4*)(gK + j_ * 8192 + 4096); \
        vreg[0] = *(const u32x4*)(gV + j_ * 8192); vreg[1] = *(const u32x4*)(gV + j_ * 8192 + 4096); if (!DIFF && tid < 64) creg = c2g[head * SEQ + j_ * 64 + tid]; } while (0)
#define ATT_WRITE(b) do { LAS unsigned char* bp_ = lds + (b) * BUF; *(LAS u32x4*)(bp_ + lK) = kreg[0]; if (!DIFF) *(LAS u32x4*)(bp_ + lK + 32 * KROW) = kreg[1]; \
        *(LAS u32x4*)(bp_ + lV) = vreg[0]; *(LAS u32x4*)(bp_ + lV + 64 * VROW) = vreg[1]; if (!DIFF && tid < 64) *(LAS float*)(bp_ + C2_OFF + tid * 4) = creg; } while (0)
#pragma unroll
        for (int db = 0; db < 4; ++db)
#pragma unroll
            for (int i = 0; i < 16; ++i) O[db][i] = 0.f;
        float m = DIFF ? slope2 * (float)toff : c2g[head * SEQ + trow], l = 0.f;
        asm volatile("" : "+v"(m));
        ATT_LOAD(jmax); ATT_WRITE(0);
        __syncthreads();
        int cur = 0;
        for (int j = jmax; j >= jmin; --j) {
            if (j > jd) { if (j > jmin) ATT_LOAD(j - 1); }
            if (j <= jd) {
                const bool diag = (j == jd);
                const LAS unsigned char* bp = lds + cur * BUF;
                if (__any(l > 1.8446744e19f)) {
                    const float a = 5.421010862e-20f; l *= a; m += 64.f;
#pragma unroll
                    for (int db = 0; db < 4; ++db) O[db] *= a;
                }
                if (DIFF && !diag) m += 64.f * slope2;
                f32x16 S0, S1;
                bf16x8 kfa[NX], kfb[DIFF ? NX : 1];
#pragma unroll
                for (int x = 0; x < NX; ++x) { kfa[x] = *(const LAS bf16x8*)(bp + rK + x * 32); if (DIFF) kfb[x] = *(const LAS bf16x8*)(bp + rK + 32 * KROW + x * 32); }
                asm volatile("" ::: "memory");
                if (DIFF) {
                    if (diag) { int toff_v = toff, h_v = 8 * h; asm volatile("" : "+v"(toff_v), "+v"(h_v)); const float tf = (float)toff_v, hf = (float)h_v, base = slope2 * tf - m;
#pragma unroll
                        for (int i = 0; i < 16; ++i) { const float ko = (float)(16 * (i >> 3) + (i & 7)) + hf; S0[i] = base - slope2 * fabsf(ko - tf); S1[i] = base - slope2 * fabsf(ko + 32.f - tf); } }
                    else { const float base = slope2 * (float)(8 * h) - m;
#pragma unroll
                        for (int i = 0; i < 16; ++i) { S0[i] = fmaf(slope2, (float)(16 * (i >> 3) + (i & 7)), base); S1[i] = fmaf(slope2, (float)(32 + 16 * (i >> 3) + (i & 7)), base); } }
                } else {
                    const LAS f32x4* cp = (const LAS f32x4*)(bp + C2_OFF + (8 * h) * 4);
                    const f32x4 c0 = cp[0], c1 = cp[1], c2v = cp[4], c3 = cp[5], d0 = cp[8], d1 = cp[9], d2 = cp[12], d3 = cp[13];
#pragma unroll
                    for (int i = 0; i < 4; ++i) { S0[i] = c0[i] - m; S0[4 + i] = c1[i] - m; S0[8 + i] = c2v[i] - m; S0[12 + i] = c3[i] - m;
                                                  S1[i] = d0[i] - m; S1[4 + i] = d1[i] - m; S1[8 + i] = d2[i] - m; S1[12 + i] = d3[i] - m; }
                }
                __builtin_amdgcn_s_setprio(2);
                if (DIFF) {
#pragma unroll
                    for (int x = 0; x < NX; ++x) { S0 = MFMA32(kfa[x], qf[x], S0); S1 = MFMA32(kfb[x], qf[x], S1); }
                } else {
#pragma unroll
                    for (int x = 0; x < NX; ++x) S0 = MFMA32(kfa[x], qf[x], S0);
#pragma unroll
                    for (int x = 0; x < NX; ++x) kfa[x] = *(const LAS bf16x8*)(bp + rK + 32 * KROW + x * 32);
                    asm volatile("" ::: "memory");
#pragma unroll
                    for (int x = 0; x < NX; ++x) S1 = MFMA32(kfa[x], qf[x], S1);
                }
                if (j > jmin) ATT_LOAD(j - 1);
                bf16x8 vf0[8], vf1[8];
#pragma unroll
                for (int s = 0; s < 2; ++s)
#pragma unroll
                    for (int db = 0; db < 4; ++db) vf0[s * 4 + db] = *(const LAS bf16x8*)(bp + rV + db * 32 * VROW + s * 32);
                asm volatile("" ::: "memory");
                if (diag) {
                    if (!DIFF) { int toff_v = toff - 8 * h; asm volatile("" : "+v"(toff_v));
#pragma unroll
                        for (int i = 0; i < 16; ++i) { const int ko = 16 * (i >> 3) + (i & 7); if (ko > toff_v) S0[i] = -INFINITY; if (ko + 32 > toff_v) S1[i] = -INFINITY; } }
                    float tm = S0[0];
#pragma unroll
                    for (int i = 1; i < 16; ++i) tm = fmaxf(tm, S0[i]);
#pragma unroll
                    for (int i = 0; i < 16; ++i) tm = fmaxf(tm, S1[i]);
                    tm = fmaxf(tm, __shfl_xor(tm, 32));
                    m += tm;
#pragma unroll
                    for (int i = 0; i < 16; ++i) { S0[i] -= tm; S1[i] -= tm; }
                }
                bf16x8 pf0[2], pf1[2];
                float ls = 0.f;
#pragma unroll
                for (int i = 0; i < 16; ++i) { S0[i] = fast_exp2(S0[i]); ls += S0[i]; }
                pack_p(S0, pf0);
#pragma unroll
                for (int s = 0; s < 2; ++s)
#pragma unroll
                    for (int db = 0; db < 4; ++db) O[db] = MFMA32(vf0[s * 4 + db], pf0[s], O[db]);
#pragma unroll
                for (int s = 0; s < 2; ++s)
#pragma unroll
                    for (int db = 0; db < 4; ++db) vf1[s * 4 + db] = *(const LAS bf16x8*)(bp + rV + db * 32 * VROW + 64 + s * 32);
                asm volatile("" ::: "memory");
#pragma unroll
                for (int i = 0; i < 16; ++i) { S1[i] = fast_exp2(S1[i]); ls += S1[i]; }
                pack_p(S1, pf1);
                l += ls;
#pragma unroll
                for (int s = 0; s < 2; ++s)
#pragma unroll
                    for (int db = 0; db < 4; ++db) O[db] = MFMA32(vf1[s * 4 + db], pf1[s], O[db]);
                __builtin_amdgcn_s_setprio(0);
            }
            if (j > jmin) ATT_WRITE(cur ^ 1);
            __syncthreads();
            cur ^= 1;
        }
        l += __shfl_xor(l, 32);
        const float il = (DIFF && mpc == 1) ? -lam / l : 1.f / l;
#pragma unroll
        for (int db = 0; db < 4; ++db) O[db] *= il;
        if (DIFF && both) {
            float* pk = park + tid * 64;
            if (pass == 0) {
#pragma unroll
                for (int db = 0; db < 4; ++db)
#pragma unroll
                    for (int g = 0; g < 4; ++g) *(f32x4*)(pk + db * 16 + 4 * g) = (f32x4){O[db][4 * g], O[db][4 * g + 1], O[db][4 * g + 2], O[db][4 * g + 3]};
            } else {
#pragma unroll
                for (int db = 0; db < 4; ++db)
#pragma unroll
                    for (int g = 0; g < 4; ++g) { const f32x4 pv = *(const f32x4*)(pk + db * 16 + 4 * g);
#pragma unroll
                        for (int i = 0; i < 4; ++i) O[db][4 * g + i] += pv[i]; }
            }
        }
#undef ATT_LOAD
#undef ATT_WRITE
    }
    asm volatile("" ::: "memory");
    if (DIFF && both) {
        float ss = 0.f;
#pragma unroll
        for (int db = 0; db < 4; ++db)
#pragma unroll
            for (int i = 0; i < 16; ++i) ss += O[db][i] * O[db][i];
        ss += __shfl_xor(ss, 32);
        const float rinv = fast_rsq(ss * (1.f / 128.f) + EPS) * 0.8f;
#pragma unroll
        for (int db = 0; db < 4; ++db)
#pragma unroll
            for (int g = 0; g < 4; ++g) { const f32x4 sgv = *(const f32x4*)(subln + 32 * db + 8 * g + 4 * h);
#pragma unroll
                for (int i = 0; i < 4; ++i) O[db][4 * g + i] *= rinv * sgv[i]; }
    }
    bf16_t* op = ((DIFF && both) ? OAf : Og + (DIFF ? (size_t)mp * ((size_t)SEQ * 1024) : (size_t)0)) + (size_t)trow * 1024 + head * 128 + 4 * h;
#pragma unroll
    for (int db = 0; db < 4; ++db)
#pragma unroll
        for (int g = 0; g < 4; ++g) { u32x2 o; o.x = cvt_pk_bf16(O[db][4 * g], O[db][4 * g + 1]); o.y = cvt_pk_bf16(O[db][4 * g + 2], O[db][4 * g + 3]);
            *(u32x2*)(op + 32 * db + 8 * g) = o; }
}
}

#define XB_TMO      128
#define XB_XCNT(j)  (256  + 64 * (j))
#define XB_XSUB(j)  (1280 + 64 * (j))
#define XB_XGEN(j)  (2304 + 64 * (j))
#define XB_TOP      3328
#define XB_TOPGEN   3392
#define XCD_BAR_WORDS 3456
#define XB_SPIN_CAP (1u << 22)
__device__ __forceinline__ unsigned xb_ld(unsigned* p)              { return __hip_atomic_load(p, __ATOMIC_RELAXED, __HIP_MEMORY_SCOPE_AGENT); }
__device__ __forceinline__ unsigned xb_add(unsigned* p, unsigned v) { return __hip_atomic_fetch_add(p, v, __ATOMIC_RELAXED, __HIP_MEMORY_SCOPE_AGENT); }
__device__ __forceinline__ unsigned xb_xcc_id() { return (unsigned)__builtin_amdgcn_s_getreg((3 << 11) | 20) & 0xFu; }
#define XB_SPIN(cond, bar) do { unsigned _sp = 0; while (cond) { __builtin_amdgcn_s_sleep(1); \
    if ((++_sp & 255u) == 0u) { if (xb_ld(&(bar)[XB_TMO])) break; if (_sp > XB_SPIN_CAP) { atomicAdd(&(bar)[XB_TMO], 1u); break; } } } } while (0)
struct XcdBarrier { unsigned* bar; unsigned x; volatile LAS unsigned* st; };
__device__ __forceinline__ XcdBarrier xcd_barrier_post(unsigned* bar, volatile LAS unsigned* st) {
    XcdBarrier b; b.bar = bar; b.x = xb_xcc_id(); b.st = st;
    if (threadIdx.x == 0) (void)xb_add(&bar[XB_XCNT(b.x)], 1u);
    return b;
}
__device__ __forceinline__ void xcd_barrier_complete(unsigned* bar, unsigned x, unsigned& nloc, unsigned& nx) {
    const unsigned G = gridDim.x * gridDim.y * gridDim.z;
    unsigned sum, cnt, mine, sp = 0u;
    for (;;) {
        sum = 0u; cnt = 0u; mine = 0u;
#pragma unroll
        for (unsigned j = 0; j < 16; ++j) { const unsigned c = xb_ld(&bar[XB_XCNT(j)]); sum += c; cnt += (c > 0u) ? 1u : 0u; mine = (j == x) ? c : mine; }
        if (sum == G) break;
        __builtin_amdgcn_s_sleep(1);
        if ((++sp & 255u) == 0u) { if (xb_ld(&bar[XB_TMO])) break; if (sp > XB_SPIN_CAP) { atomicAdd(&bar[XB_TMO], 1u); break; } }
    }
    nloc = mine > 0u ? mine : 1u; nx = cnt > 0u ? cnt : 1u;
}
__device__ __forceinline__ void xcd_barrier(const XcdBarrier& b) {
    asm volatile("s_waitcnt vmcnt(0)" ::: "memory");
    __syncthreads();
    if (threadIdx.x == 0) {
        unsigned* bar = b.bar;
        __builtin_amdgcn_s_waitcnt(0);
        unsigned nloc = b.st[0], nx = b.st[1];
        if (nloc == 0u) { xcd_barrier_complete(bar, b.x, nloc, nx); b.st[0] = nloc; b.st[1] = nx; }
        const unsigned k = b.st[2]; b.st[2] = k + 1u;
        const unsigned old = xb_add(&bar[XB_XSUB(b.x)], 1u);
        const unsigned gen = old / nloc;
        if (old + 1u == (gen + 1u) * nloc) {
            __builtin_amdgcn_fence(__ATOMIC_RELEASE, "agent");
            asm volatile("s_waitcnt vmcnt(0)" ::: "memory");
            const unsigned og = xb_add(&bar[XB_TOP], 1u);
            const unsigned tg = og / nx;
            if (og + 1u == (tg + 1u) * nx) xb_add(&bar[XB_TOPGEN], 1u);
        }
        XB_SPIN(xb_ld(&bar[XB_TOPGEN]) == k, bar);
        __builtin_amdgcn_fence(__ATOMIC_ACQUIRE, "agent");
        asm volatile("s_waitcnt vmcnt(0)" ::: "memory");
    }
    __syncthreads();
}

struct Args { const float* in[21]; float* out; unsigned char* ws; int ph_lo, ph_hi, att_sel, pad; };

__global__ void __launch_bounds__(NTHREADS, 2) fwd_kernel(Args args) {
    extern __shared__ __attribute__((aligned(16))) unsigned char lds_raw[];
    LAS unsigned char* lds = (LAS unsigned char*)lds_raw;
    const int tid = threadIdx.x, lane = tid & 63, wave = __builtin_amdgcn_readfirstlane(tid >> 6);
    const int G = gridDim.x, bx = blockIdx.x;
    const int vcu = (G % 8 == 0) ? (bx % 8) * (G / 8) + bx / 8 : bx;
    unsigned char* ws = args.ws;
    const float* x = args.in[0];       const float* norm_mix = args.in[1]; const float* w_in = args.in[2];   const float* b_forget = args.in[3];
    const float* qn_diff = args.in[4]; const float* kn_diff = args.in[5];  const float* lq1 = args.in[6];    const float* lk1 = args.in[7];
    const float* lq2 = args.in[8];     const float* lk2 = args.in[9];      const float* subln = args.in[10]; const float* qn_fox = args.in[11];
    const float* kn_fox = args.in[12]; const float* w_bd = args.in[13];    const float* w_bf = args.in[14];  const float* w_gate = args.in[15];
    const float* b_gate = args.in[16]; const float* w_out = args.in[17];   const float* norm_mlp = args.in[18]; const float* w_up = args.in[19];
    const float* w_down = args.in[20];
    float* out = args.out;
    float* LF = (float*)(ws + WS_LF); float* C2 = (float*)(ws + WS_C2); float* SS2 = (float*)(ws + WS_SS2); float* GN = (float*)(ws + WS_GN);
    bf16_t *Wbd = (bf16_t*)(ws + WS_WBD), *Wbf = (bf16_t*)(ws + WS_WBF), *Wout = (bf16_t*)(ws + WS_WOUT), *Wt1 = (bf16_t*)(ws + WS_WT1), *Wt2 = (bf16_t*)(ws + WS_WT2);
    bf16_t *Wup = (bf16_t*)(ws + WS_WUP), *Wdown = (bf16_t*)(ws + WS_WDOWN), *H = (bf16_t*)(ws + WS_H);
    bf16_t *QA = (bf16_t*)(ws + WS_QA), *KA = (bf16_t*)(ws + WS_KA), *QB = (bf16_t*)(ws + WS_QB), *KB = (bf16_t*)(ws + WS_KB), *VT = (bf16_t*)(ws + WS_VT);
    bf16_t *Gt = (bf16_t*)(ws + WS_G), *OA = (bf16_t*)(ws + WS_OA), *OB = (bf16_t*)(ws + WS_OB), *MG = (bf16_t*)(ws + WS_MG), *XG = (bf16_t*)(ws + WS_XG), *U = (bf16_t*)(ws + WS_U);
    bf16_t* MGT = (bf16_t*)(ws + WS_MGT);
    const int lo = args.ph_lo, hi = args.ph_hi;
    const int gw = vcu * NWAVES + wave, NGW = G * NWAVES;
#ifndef PH_MASK
#define PH_MASK 0xff
#endif
#define IN(k) (((PH_MASK >> (k)) & 1) && lo <= (k) && (k) < hi)
#define SEAM(k) do { if (IN(k) && IN((k) + 1)) { if (args.pad != 0) cg::this_grid().sync(); else xcd_barrier(xbar); } } while (0)
    XcdBarrier xbar; xbar.bar = (unsigned*)(ws + WS_CTL) + 1024; xbar.x = 0; xbar.st = (volatile LAS unsigned*)(lds + LDS_BAR_OFF);
    if (hi - lo > 1) {
        if (tid < 3) ((volatile LAS unsigned*)(lds + LDS_BAR_OFF))[tid] = 0u;
        __syncthreads();
        xbar = xcd_barrier_post((unsigned*)(ws + WS_CTL) + 1024, (volatile LAS unsigned*)(lds + LDS_BAR_OFF));
    }

    if (IN(0)) {
        LAS float* scr = (LAS float*)(lds + wave * P0_SCR_STRIDE);
        LAS float* wf = (LAS float*)(lds + P0_WF_OFF);
        if (bx == 0) { if (tid < 64) { GN[tid] = qn_diff[tid] * (0.125f * LOG2E); GN[128 + tid] = kn_diff[tid]; } if (tid < 128) { GN[256 + tid] = qn_fox[tid] * (0.08838834764831845f * LOG2E); GN[384 + tid] = kn_fox[tid]; } }
        for (int k = tid; k < DM; k += NTHREADS) { const f32x4 a = *(const f32x4*)(w_in + (size_t)k * NPROJ + 6144), b = *(const f32x4*)(w_in + (size_t)k * NPROJ + 6148);
            wf[0 * DM + k] = a[0]; wf[1 * DM + k] = a[1]; wf[2 * DM + k] = a[2]; wf[3 * DM + k] = a[3]; wf[4 * DM + k] = b[0]; wf[5 * DM + k] = b[1]; wf[6 * DM + k] = b[2]; wf[7 * DM + k] = b[3]; }
        __syncthreads();
        constexpr int I0 = 2048, I1 = 2048, I2 = 4096, I3 = 1024, I4 = 1024, NIT = I0 + I1 + I2 + I3 + I4;
        for (int it = gw; it < NIT; it += NGW) {
            int q = it;
            if (q < I0) { transpose_item(w_in, NPROJ, 0, 2048, DM, Wt1, 0, scr, q, lane); continue; } q -= I0;
            if (q < I1) { transpose_item(w_in, NPROJ, 3072, 2048, DM, Wt1, 2048, scr, q, lane); continue; } q -= I1;
            if (q < I2) { transpose_item(w_gate, 4096, 0, 4096, DM, Wt1, 4096, scr, q, lane); continue; } q -= I2;
            if (q < I3) { transpose_item(w_in, NPROJ, 2048, 1024, DM, Wt2, 0, scr, q, lane); continue; } q -= I3;
            transpose_item(w_in, NPROJ, 5120, 1024, DM, Wt2, 1024, scr, q, lane);
        }
        for (int row = gw; row < SEQ; row += NGW) {
            const f32x4* xr = (const f32x4*)(x + (size_t)row * DM) + lane;
            f32x4 v[8]; float s = 0.f;
#pragma unroll
            for (int j = 0; j < 8; ++j) { v[j] = xr[64 * j]; s += (v[j][0] * v[j][0] + v[j][1] * v[j][1]) + (v[j][2] * v[j][2] + v[j][3] * v[j][3]); }
            const float rinv = fast_rsq(wave_sum(s) * (1.f / DM) + EPS);
            float a0 = 0.f, a1 = 0.f, a2 = 0.f, a3 = 0.f, a4 = 0.f, a5 = 0.f, a6 = 0.f, a7 = 0.f;
            u32x2* hp = (u32x2*)(H + (size_t)row * DM) + lane;
#pragma unroll
            for (int j = 0; j < 8; ++j) { const f32x4 gg = ((const f32x4*)norm_mix)[lane + 64 * j]; const f32x4 hv = v[j] * rinv * gg;
                u32x2 o; o.x = cvt_pk_bf16(hv[0], hv[1]); o.y = cvt_pk_bf16(hv[2], hv[3]); hp[64 * j] = o;
                const LAS f32x4* wp = (const LAS f32x4*)wf + lane + 64 * j;
#define FDOT(acc_, jj) { const f32x4 w4 = wp[(jj) * (DM / 4)]; acc_ += (hv[0] * w4[0] + hv[1] * w4[1]) + (hv[2] * w4[2] + hv[3] * w4[3]); }
                FDOT(a0, 0) FDOT(a1, 1) FDOT(a2, 2) FDOT(a3, 3) FDOT(a4, 4) FDOT(a5, 5) FDOT(a6, 6) FDOT(a7, 7)
                asm volatile("" ::: "memory");
#undef FDOT
            }
            a0 = wave_sum(a0); a1 = wave_sum(a1); a2 = wave_sum(a2); a3 = wave_sum(a3); a4 = wave_sum(a4); a5 = wave_sum(a5); a6 = wave_sum(a6); a7 = wave_sum(a7);
            if (lane < 8) { float z = lane == 0 ? a0 : lane == 1 ? a1 : lane == 2 ? a2 : lane == 3 ? a3 : lane == 4 ? a4 : lane == 5 ? a5 : lane == 6 ? a6 : a7;
                z += b_forget[lane]; LF[(size_t)lane * SEQ + row] = fminf(z, 0.f) - log1pf(expf(-fabsf(z))); }
        }
        __syncthreads();
    }
    SEAM(0);

    if (IN(1)) {
        {
            pg8::Gemm g{H, Wt2, Wt1, H, DM};
            pg8::P1Order S{G, bx};
            pg8::EpiP1 E{QA, Gt, VT, GN, b_gate};
            pg8::gemm_phase(lds, g, S, E);
        }
        __syncthreads();
        if (bx < 8) {
            LAS double* wsum = (LAS double*)lds;
            const int j = bx; float vals[16]; double s = 0.0;
#pragma unroll
            for (int i = 0; i < 16; ++i) { vals[i] = LF[(size_t)j * SEQ + 16 * tid + i]; s += (double)vals[i]; }
            double inc = s;
#pragma unroll
            for (int o = 1; o < 64; o <<= 1) { const double t = __shfl_up(inc, o); if (lane >= o) inc += t; }
            if (lane == 63) wsum[wave] = inc;
            __syncthreads();
            double run = inc - s;
            for (int q = 0; q < wave; ++q) run += wsum[q];
#pragma unroll
            for (int i = 0; i < 16; ++i) { run += (double)vals[i]; C2[(size_t)j * SEQ + 16 * tid + i] = (float)(-run * (double)LOG2E); }
            __syncthreads();
        }
    }
    SEAM(1);

    if (IN(2)) {
        float lam;
        { const float p1 = wave_sum(lq1[lane] * lk1[lane]), p2 = wave_sum(lq2[lane] * lk2[lane]); lam = expf(p1) - expf(p2) + 0.2f; }
        unsigned* ctl = (unsigned*)(ws + WS_CTL);
        LAS unsigned* qh = (LAS unsigned*)(lds + 8 * 16640 + 64);
        constexpr int TR_IU = 32 * 128, TR_ID = 128 * 32, TR_IB = 16 * 32, TR_IO = 32 * 32, TR_NQ = TR_IU + TR_ID + 2 * TR_IB + TR_IO;
#define TR_ROUNDS(n) do { int lane_ = lane, wave_ = wave; asm volatile("" : "+v"(lane_), "+s"(wave_));     \
        LAS float* scr_ = (LAS float*)(lds + wave_ * 16640); LAS unsigned* qh2_ = (LAS unsigned*)(lds + 8 * 16640); \
        for (int rd_ = 0; rd_ < (n); ++rd_) { if (tid == 0) *qh2_ = atomicAdd(ctl + 0, (unsigned)NWAVES); __syncthreads(); const int it0_ = (int)*qh2_; __syncthreads(); if (it0_ >= TR_NQ) break; \
            int q_ = it0_ + wave_; \
            if (q_ < TR_NQ) { if (q_ < TR_IU) transpose_item64(w_up, FF, FF, DM, Wup, scr_, q_, lane_, norm_mlp);     \
                else if ((q_ -= TR_IU) < TR_ID) transpose_item64(w_down, DM, DM, FF, Wdown, scr_, q_, lane_); \
                else if ((q_ -= TR_ID) < TR_IB) transpose_item64(w_bd, DM, DM, 1024, Wbd, scr_, q_, lane_); \
                else if ((q_ -= TR_IB) < TR_IB) transpose_item64(w_bf, DM, DM, 1024, Wbf, scr_, q_, lane_); \
                else transpose_item64(w_out, DM, DM, DM, Wout, scr_, q_ - TR_IB, lane_); } } } while (0)
#define NEXT_JOB(word, step, dst) do { if (tid == 0) *qh = atomicAdd(ctl + (word), (unsigned)(step)); __syncthreads(); dst = (int)*qh; __syncthreads(); } while (0)
#ifndef ATT_SKIP_DIFF
        if (args.att_sel != 2) for (;;) {
            int job; NEXT_JOB(1, 1, job); if (job >= 512) break;
            const int qb = 31 - (job >> 4), r = job & 15;
            const bool both = r >= 6;
            if (both && (r & 1)) continue;
            att::attn_unit<true>(lds, QA, KA, VT, nullptr, (bf16_t*)out, out + (size_t)SEQ * 1024 + (size_t)bx * (64 * NTHREADS), 7 - (r >> 1), qb, r & 1, lam, GN, both, OA, subln);
            if (args.att_sel == 0) TR_ROUNDS(2);
        }
#endif
#ifndef ATT_SKIP_FOX
        if (args.att_sel != 1) for (;;) {
            int job; NEXT_JOB(2, 1, job); if (job >= 256) break;
            att::attn_unit<false>(lds, QB, KB, VT + (size_t)1024 * SEQ, C2, OB, nullptr, job & 7, 31 - (job >> 3), 0, 0.f, GN);
            if (args.att_sel == 0) TR_ROUNDS(1);
        }
#endif
        if (args.att_sel == 0) TR_ROUNDS(1 << 30);
#undef NEXT_JOB
#undef TR_ROUNDS
    }
    SEAM(2);

    if (IN(3)) {
        const bf16_t* o0 = (const bf16_t*)out; const bf16_t* o1 = o0 + (size_t)SEQ * 1024;
        f32x4 sg[4];
#pragma unroll
        for (int i = 0; i < 4; ++i) sg[i] = *(const f32x4*)(subln + (lane & 7) * 16 + 4 * i) * 0.8f;
        for (int row = gw; row < SEQ; row += NGW) {
            const size_t off = (size_t)row * 1024 + lane * 16;
            if (lane < 40) continue;
            f32x4 v[4]; float ss = 0.f;
#pragma unroll
            for (int i = 0; i < 2; ++i) { const u32x4 a = *(const u32x4*)(o0 + off + 8 * i), b = *(const u32x4*)(o1 + off + 8 * i);
                v[2 * i] = (f32x4){bf_lo(a.x) + bf_lo(b.x), bf_hi(a.x) + bf_hi(b.x), bf_lo(a.y) + bf_lo(b.y), bf_hi(a.y) + bf_hi(b.y)};
                v[2 * i + 1] = (f32x4){bf_lo(a.z) + bf_lo(b.z), bf_hi(a.z) + bf_hi(b.z), bf_lo(a.w) + bf_lo(b.w), bf_hi(a.w) + bf_hi(b.w)}; }
#pragma unroll
            for (int i = 0; i < 4; ++i) ss += (v[i][0] * v[i][0] + v[i][1] * v[i][1]) + (v[i][2] * v[i][2] + v[i][3] * v[i][3]);
            ss += __shfl_xor(ss, 1); ss += __shfl_xor(ss, 2); ss += __shfl_xor(ss, 4);
            const float rinv = fast_rsq(ss * (1.f / 128.f) + EPS);
#pragma unroll
            for (int i = 0; i < 4; ++i) v[i] = v[i] * rinv * sg[i];
            *(u32x4*)(OA + off) = pack8(v[0], v[1]); *(u32x4*)(OA + off + 8) = pack8(v[2], v[3]);
        }
    }


    SEAM(3);

    if (IN(4)) {
        pg8::Gemm g{OA, OB, Wbd, Wbf, 1024};
        pg8::P3Order S{G, bx};
        pg8::EpiP3 E{Gt, MGT, MG};
        pg8::gemm_phase(lds, g, S, E);
    }
    SEAM(4);

    if (IN(5)) {
        pg8::Gemm g{MG, MG, Wout, Wout, DM};
        pg8::PlainOrder S{32, 8, G, bx};
        pg8::EpiP4 E{x, (bf16_t*)(ws + WS_X1B), SS2};
        pg8::gemm_phase(lds, g, S, E);
    }
    SEAM(5);

    if (IN(6)) {
        pg8::Gemm g{(const bf16_t*)(ws + WS_X1B), (const bf16_t*)(ws + WS_X1B), Wup, Wup, DM};
        pg8::PlainOrder S{32, 32, G, bx};
        pg8::Unit u0; int pm0 = -1;
        if (S.next(0, u0)) { pm0 = u0.pm;
            LAS float* tab = (LAS float*)(lds + EPI_SCR_OFF);
            if (tid < 256) { const f32x4* sp = (const f32x4*)(SS2 + (size_t)(pm0 * 256 + tid) * 32); f32x4 sa = sp[0];
#pragma unroll
                for (int q = 1; q < 8; ++q) sa += sp[q];
                tab[tid] = fast_rsq(((sa[0] + sa[1]) + (sa[2] + sa[3])) * (1.f / DM) + EPS); }
            __syncthreads(); }
        pg8::EpiP5 E{SS2, U, pm0};
        pg8::gemm_phase(lds, g, S, E);
    }
    SEAM(6);

    if (IN(7)) {
        pg8::Gemm g{U, U, Wdown, Wdown, FF};
        pg8::PlainOrder S{32, 8, G, bx};
        pg8::EpiP6 E{(const bf16_t*)(ws + WS_X1B), out};
        pg8::gemm_phase(lds, g, S, E);
    }
#undef IN
#undef SEAM
}

#ifdef PROBE_PHASE
__global__ void dump_bf16(const bf16_t* a, const bf16_t* b, float* dst, size_t nhalf) {
    for (size_t i = blockIdx.x * (size_t)blockDim.x + threadIdx.x; i < nhalf; i += (size_t)gridDim.x * blockDim.x) { dst[i] = bf_lo((unsigned)a[i]); dst[nhalf + i] = bf_lo((unsigned)b[i]); }
}
#endif
extern "C" void kernel_launch(void* const* d_in, const int* in_sizes, int n_in, void* d_out, int out_size, void* d_ws, size_t ws_size, hipStream_t stream) {
    static int grid = 0;
    if (grid == 0) {
        if (n_in != 21 || out_size != SEQ * DM || ws_size < WS_END) { fprintf(stderr, "kernel_launch: unexpected problem (n_in %d, out %d, ws %zu)\n", n_in, out_size, ws_size); grid = -1; return; }
        int dev = 0, cus = 0, per_cu = 0;
        hipGetDevice(&dev);
        hipDeviceGetAttribute(&cus, hipDeviceAttributeMultiprocessorCount, dev);
        hipFuncSetAttribute((const void*)fwd_kernel, hipFuncAttributeMaxDynamicSharedMemorySize, LDS_BYTES);
        hipOccupancyMaxActiveBlocksPerMultiprocessor(&per_cu, (const void*)fwd_kernel, NTHREADS, LDS_BYTES);
        if (per_cu < 1) { fprintf(stderr, "kernel_launch: occupancy query says %d blocks per CU\n", per_cu); per_cu = 1; }
        if (per_cu > 1) per_cu = 1;
        grid = cus * per_cu;
        (void)hipGetLastError();
    }
    if (grid < 0) return;
    (void)hipMemsetAsync((char*)d_ws + WS_CTL, 0, CTL_BYTES, stream);
    Args a{};
    for (int i = 0; i < 21; ++i) a.in[i] = (const float*)d_in[i];
    a.out = (float*)d_out; a.ws = (unsigned char*)d_ws;
#if REPEAT_PHASE >= 0
    for (int p = 0; p < 8; ++p) { a.ph_lo = p; a.ph_hi = p + 1; a.att_sel = 0; hipLaunchKernelGGL(fwd_kernel, dim3(grid), dim3(NTHREADS), LDS_BYTES, stream, a);
        if ((REPEAT_PHASE >> p) & 1) { a.att_sel = REPEAT_PHASE >> 8; (void)hipMemsetAsync((char*)d_ws + WS_CTL, 0, 64, stream); hipLaunchKernelGGL(fwd_kernel, dim3(grid), dim3(NTHREADS), LDS_BYTES, stream, a); } }
#elif MK_N_LAUNCHES == 1
    a.ph_lo = 0; a.ph_hi = 8;
    void* kargs[] = {&a};
    hipError_t e = hipLaunchCooperativeKernel((const void*)fwd_kernel, dim3(grid), dim3(NTHREADS), kargs, LDS_BYTES, stream);
    if (e != hipSuccess) fprintf(stderr, "cooperative launch failed: %s (grid %d)\n", hipGetErrorString(e), grid);
#else
#ifdef PROBE_PHASE
    for (int p = 0; p <= PROBE_PHASE; ++p) { a.ph_lo = p; a.ph_hi = p + 1; hipLaunchKernelGGL(fwd_kernel, dim3(grid), dim3(NTHREADS), LDS_BYTES, stream, a); }
    { const unsigned char* w = (const unsigned char*)d_ws; hipLaunchKernelGGL(dump_bf16, dim3(2048), dim3(256), 0, stream, (const bf16_t*)(w + PROBE_A), (const bf16_t*)(w + PROBE_B), (float*)d_out, (size_t)SEQ * 1024); }
#else
    for (int p = 0; p < 8; ++p) { a.ph_lo = p; a.ph_hi = p + 1; hipLaunchKernelGGL(fwd_kernel, dim3(grid), dim3(NTHREADS), LDS_BYTES, stream, a); }
#endif
#endif
}
```

```cpp
#include <hip/hip_runtime.h>
#include <hip/hip_cooperative_groups.h>
#include <cstdio>
#include <cstdint>
namespace cg = cooperative_groups;

#ifndef REPEAT_PHASE
#define REPEAT_PHASE -1
#endif
#ifndef MK_N_LAUNCHES
#define MK_N_LAUNCHES 1
#endif

#define LAS __attribute__((address_space(3)))
typedef unsigned short bf16_t;
typedef short bf16x8 __attribute__((ext_vector_type(8)));
typedef float f32x4 __attribute__((ext_vector_type(4)));
typedef float f32x16 __attribute__((ext_vector_type(16)));
typedef unsigned u32x4 __attribute__((ext_vector_type(4)));
typedef unsigned u32x2 __attribute__((ext_vector_type(2)));

constexpr int SEQ = 8192, DM = 2048, NPROJ = 6152, FF = 8192;
constexpr float EPS = 1e-6f, LOG2E = 1.4426950408889634f;
constexpr int NTHREADS = 512, NWAVES = 8;

constexpr size_t MiB = 1u << 20;
constexpr size_t WS_LF = 0;
constexpr size_t WS_C2 = 256 * 1024;
constexpr size_t WS_GN = 512 * 1024;
constexpr size_t WS_CTL = 768 * 1024;
constexpr size_t CTL_BYTES = 32768;
constexpr size_t WS_SS2 = 1 * MiB;
constexpr size_t WS_WBD = 8 * MiB, WS_WBF = 12 * MiB, WS_WOUT = 16 * MiB;
constexpr size_t WS_WT1 = 24 * MiB, WS_WUP = 24 * MiB;
constexpr size_t WS_WT2 = 56 * MiB;
constexpr size_t WS_H = 64 * MiB, WS_WDOWN = 64 * MiB;
constexpr size_t WS_QA = 96 * MiB, WS_KA = 112 * MiB, WS_QB = 128 * MiB, WS_KB = 144 * MiB;
constexpr size_t WS_MGT = 96 * MiB;
constexpr size_t WS_VT = 160 * MiB, WS_MG = 160 * MiB;
constexpr size_t WS_G = 192 * MiB;
constexpr size_t WS_OA = 256 * MiB, WS_OB = 272 * MiB, WS_XG = 256 * MiB;
constexpr size_t WS_X1B = 224 * MiB;
constexpr size_t WS_U = 96 * MiB;
constexpr size_t WS_END = 288 * MiB;

constexpr int GEMM_LDS = 131072;
constexpr int EPI_SCR_OFF = GEMM_LDS;
constexpr int LDS_BYTES = GEMM_LDS + 4096 + 1024;
constexpr int LDS_BAR_OFF = LDS_BYTES - 16;
constexpr int P0_SCR_STRIDE = 8704, P0_WF_OFF = 8 * P0_SCR_STRIDE;
static_assert(P0_WF_OFF + 65536 <= LDS_BAR_OFF, "P0 LDS map");

typedef float f32x2_t __attribute__((ext_vector_type(2)));
typedef __bf16 bf16x2_t __attribute__((ext_vector_type(2)));
__device__ __forceinline__ unsigned cvt_pk_bf16(float lo, float hi) { const f32x2_t v = {lo, hi}; const bf16x2_t b = __builtin_convertvector(v, bf16x2_t); return __builtin_bit_cast(unsigned, b); }
__device__ __forceinline__ u32x4 pack8(const f32x4& a, const f32x4& b) { u32x4 w; w.x = cvt_pk_bf16(a[0], a[1]); w.y = cvt_pk_bf16(a[2], a[3]); w.z = cvt_pk_bf16(b[0], b[1]); w.w = cvt_pk_bf16(b[2], b[3]); return w; }
__device__ __forceinline__ float bf_lo(unsigned u) { return __uint_as_float(u << 16); }
__device__ __forceinline__ float bf_hi(unsigned u) { return __uint_as_float(u & 0xffff0000u); }
__device__ __forceinline__ float fast_exp2(float x) { return __builtin_amdgcn_exp2f(x); }
__device__ __forceinline__ float fast_rcp(float x) { return __builtin_amdgcn_rcpf(x); }
__device__ __forceinline__ float fast_rsq(float x) { return __builtin_amdgcn_rsqf(x); }
__device__ __forceinline__ float wave_sum(float v) {
#pragma unroll
    for (int o = 1; o < 64; o <<= 1) v += __shfl_xor(v, o);
    return v;
}
#define LDS_WAIT() asm volatile("s_waitcnt lgkmcnt(0)" ::: "memory")

namespace pg8 {
constexpr int BM = 256, BK = 64, HALF = 128, HTB = HALF * BK * 2, STAGE_BYTES = 8 * HTB, NXCD = 8, WGM = 4;
__host__ __device__ __forceinline__ int lds_byte(int r, int c) { const int st = (r >> 4) * 2 + (c >> 5), rr = r & 15, cc = c & 31, ob = rr * 64 + cc * 2; return st * 1024 + (ob ^ (((ob >> 9) & 1) << 5)); }
__host__ __device__ __forceinline__ void stage_rc(int b, int& R, int& C) { const int st = b / 1024, sb = b % 1024, swz = sb ^ (((sb >> 9) & 1) << 5); R = (st >> 1) * 16 + swz / 64; C = (st & 1) * 32 + (swz % 64) / 2; }
__host__ __device__ __forceinline__ int perm32(int rho) { const int n = rho >> 4, i = rho & 15; return 8 * (i >> 2) + 4 * n + (i & 3); }

struct Unit { int pm, pn, sel; };
struct Gemm { const bf16_t *A0, *A1, *B0, *B1; int K; };

__host__ __device__ __forceinline__ void map_tile(int L, int nM, int nN, Unit& u) {
    const int nwg = nM * nN; int wgid = L;
    { const int q = nwg / NXCD, r = nwg % NXCD, xcd = wgid % NXCD, off = wgid / NXCD; wgid = (xcd < r ? xcd * (q + 1) : r * (q + 1) + (xcd - r) * q) + off; }
    const int nig = WGM * nN, gid = wgid / nig, fm = gid * WGM, gsz = (nM - fm) < WGM ? (nM - fm) : WGM;
    u.pm = fm + ((wgid % nig) % gsz); u.pn = (wgid % nig) / gsz;
}
struct PlainOrder { int nM, nN, G, c;
    __device__ __forceinline__ bool next(int i, Unit& u) const { const long L = (long)i * G + c; if (L >= (long)nM * nN) return false; map_tile((int)L, nM, nN, u); u.sel = 0; return true; } };
struct P1Order { int G, c;
    __device__ __forceinline__ bool next(int i, Unit& u) const { long L = (long)i * G + c; if (L < 1024) { map_tile((int)L, 32, 32, u); u.sel = 0; return true; } L -= 1024; if (L < 256) { const int xcd = (int)L & 7, off = (int)L >> 3; u.pm = off & 7; u.pn = 4 * xcd + (off >> 3);     u.sel = 1; return true; } return false; } };
struct P3Order { int G, c;
    __device__ __forceinline__ bool next(int i, Unit& u) const { const long L = (long)(i >> 1) * G + c; if (L >= 256) return false; map_tile((int)L, 32, 8, u); u.sel = i & 1; return true; } };

template <class Epi, class Sched>
__device__ __forceinline__ void gemm_phase(LAS unsigned char* lds, const Gemm g, const Sched& S, const Epi& E) {
    const int tid = threadIdx.x, wid = __builtin_amdgcn_readfirstlane(tid >> 6), lane = tid & 63, wr = wid >> 2, wc = wid & 3, fr = lane & 15, fq = lane >> 4;
    const int K = g.K, nt = K / BK;
    unsigned voffA[2], voffB[2];
#pragma unroll
    for (int i = 0; i < 2; ++i) { int R, C; stage_rc(tid * 16 + i * 8192, R, C); const int Rb = 64 * (R >> 5) + perm32(R & 31);
        voffA[i] = (unsigned)(R * K + C) * 2u; voffB[i] = (unsigned)(Rb * K + C) * 2u; }
    const size_t kstep = (size_t)(BK * 2);
    const size_t hstep = (size_t)HALF * K * 2;
    const size_t hstepB = (size_t)32 * K * 2;
    const size_t tstep = 2 * hstep;
    const unsigned ldsw = (unsigned)wid * 1024u;
    const int aoff = lds_byte(wr * 64 + fr, fq * 8), boff = lds_byte(wc * 32 + fr, fq * 8);
#define PG8_SA(b, h) (((b) * 2 + (h)) * HTB)
#define PG8_SB(b, h) ((4 + (b) * 2 + (h)) * HTB)
#define PG8_STAGE(bufoff, gbase, voff) do { _Pragma("unroll") for (int _i = 0; _i < 2; ++_i) \
        __builtin_amdgcn_global_load_lds((const unsigned*)((const char*)(gbase) + (voff)[_i]), (LAS unsigned*)(lds + (bufoff) + ldsw + _i * 8192), 16, 0, 0); } while (0)
#define PG8_LDA(dst, b, h) do { _Pragma("unroll") for (int m = 0; m < 4; ++m) _Pragma("unroll") for (int k = 0; k < 2; ++k) dst[m][k] = *(const LAS bf16x8*)(lds + PG8_SA(b, h) + aoff + m * 2048 + k * 1024); } while (0)
#define PG8_LDB(dst, b, h) do { _Pragma("unroll") for (int n = 0; n < 2; ++n) _Pragma("unroll") for (int k = 0; k < 2; ++k) dst[n][k] = *(const LAS bf16x8*)(lds + PG8_SB(b, h) + boff + n * 2048 + k * 1024); } while (0)
#define PG8_MMA(ai, bj, At, Bt) do { __builtin_amdgcn_s_setprio(1); _Pragma("unroll") for (int m = 0; m < 4; ++m) _Pragma("unroll") for (int n = 0; n < 2; ++n) _Pragma("unroll") for (int k = 0; k < 2; ++k) \
        acc[ai][bj][m][n] = __builtin_amdgcn_mfma_f32_16x16x32_bf16(Bt[n][k], At[m][k], acc[ai][bj][m][n], 0, 0, 0); __builtin_amdgcn_s_setprio(0); } while (0)
#define PG8_WAIT_V(n) asm volatile("s_waitcnt vmcnt(" #n ")" ::: "memory")
#define PG8_WAIT_L(n) asm volatile("s_waitcnt lgkmcnt(" #n ")" ::: "memory")
#define PG8_BAR __builtin_amdgcn_s_barrier()
#define PG8_SCHED __builtin_amdgcn_sched_barrier(0)
    Unit cur, nxt; int ui = 0;
    if (!S.next(0, cur)) return;
    f32x4 acc[2][2][4][2];
#pragma unroll
    for (int a = 0; a < 2; ++a)
#pragma unroll
        for (int b = 0; b < 2; ++b)
#pragma unroll
            for (int m = 0; m < 4; ++m)
#pragma unroll
                for (int n = 0; n < 2; ++n) acc[a][b][m][n] = (f32x4){0.f, 0.f, 0.f, 0.f};
    bf16x8 At[4][2], B0[2][2], B1[2][2];
    const char* cA = (const char*)(cur.sel ? g.A1 : g.A0) + (size_t)cur.pm * tstep; const char* cB = (const char*)(cur.sel ? g.B1 : g.B0) + (size_t)cur.pn * tstep;
    PG8_STAGE(PG8_SB(0, 0), cB, voffB); PG8_STAGE(PG8_SB(0, 1), cB + hstepB, voffB); PG8_STAGE(PG8_SA(0, 0), cA, voffA); PG8_STAGE(PG8_SA(0, 1), cA + hstep, voffA);
    if (wr == 1) PG8_BAR;
    PG8_WAIT_V(2); PG8_BAR;
    PG8_STAGE(PG8_SB(1, 0), cB + kstep, voffB); PG8_STAGE(PG8_SA(1, 0), cA + kstep, voffA); PG8_STAGE(PG8_SB(1, 1), cB + hstepB + kstep, voffB);
    PG8_WAIT_V(6); PG8_BAR;
    for (;;) {
        const bool has_next = S.next(ui + 1, nxt);
        const char* nA = has_next ? (const char*)(nxt.sel ? g.A1 : g.A0) + (size_t)nxt.pm * tstep : cA; const char* nB = has_next ? (const char*)(nxt.sel ? g.B1 : g.B0) + (size_t)nxt.pn * tstep : cB;
        for (int t = 0; t < nt; t += 2) {
            const bool last = (t == nt - 2);
            const char* a1 = cA + (size_t)(t + 1) * kstep;
            const char* a2 = last ? nA : cA + (size_t)(t + 2) * kstep; const char* b2 = last ? nB : cB + (size_t)(t + 2) * kstep;
            const char* a3 = a2 + kstep; const char* b3 = b2 + kstep;
            PG8_LDB(B0, 0, 0); PG8_LDB(B1, 0, 1); PG8_SCHED; PG8_LDA(At, 0, 0); PG8_STAGE(PG8_SA(1, 1), a1 + hstep, voffA);
            PG8_WAIT_V(8); PG8_WAIT_L(0); PG8_BAR; PG8_MMA(0, 0, At, B0); PG8_MMA(0, 1, At, B1); PG8_BAR; PG8_SCHED;
            PG8_LDA(At, 0, 1); PG8_STAGE(PG8_SB(0, 0), b2, voffB); PG8_STAGE(PG8_SB(0, 1), b2 + hstepB, voffB); PG8_STAGE(PG8_SA(0, 0), a2, voffA);
            PG8_WAIT_V(8); PG8_WAIT_L(0); PG8_BAR; PG8_MMA(1, 0, At, B0); PG8_MMA(1, 1, At, B1); PG8_BAR; PG8_SCHED;
            PG8_LDB(B0, 1, 0); PG8_LDB(B1, 1, 1); PG8_SCHED; PG8_LDA(At, 1, 0); PG8_STAGE(PG8_SA(0, 1), a2 + hstep, voffA);
            PG8_WAIT_V(8); PG8_WAIT_L(0); PG8_BAR; PG8_MMA(0, 0, At, B0); PG8_MMA(0, 1, At, B1); PG8_BAR; PG8_SCHED;
            PG8_LDA(At, 1, 1); PG8_STAGE(PG8_SB(1, 0), b3, voffB); PG8_STAGE(PG8_SB(1, 1), b3 + hstepB, voffB); PG8_STAGE(PG8_SA(1, 0), a3, voffA);
            PG8_WAIT_V(8); PG8_WAIT_L(0); PG8_BAR; PG8_MMA(1, 0, At, B0); PG8_MMA(1, 1, At, B1); PG8_BAR; PG8_SCHED;
        }
        if (wr == 0) PG8_BAR;
        E(acc, cur, wr, wc, fr, fq, (LAS float*)(lds + EPI_SCR_OFF));
        if (!has_next) break;
#pragma unroll
        for (int a = 0; a < 2; ++a)
#pragma unroll
            for (int b = 0; b < 2; ++b)
#pragma unroll
                for (int m = 0; m < 4; ++m)
#pragma unroll
                    for (int n = 0; n < 2; ++n) acc[a][b][m][n] = (f32x4){0.f, 0.f, 0.f, 0.f};
        cur = nxt; cA = nA; cB = nB; ++ui;
        if (wr == 1) PG8_BAR;
    }
    PG8_WAIT_V(0);
    PG8_BAR;
#undef PG8_SA
#undef PG8_SB
#undef PG8_STAGE
#undef PG8_LDA
#undef PG8_LDB
#undef PG8_MMA
#undef PG8_WAIT_V
#undef PG8_WAIT_L
#undef PG8_BAR
#undef PG8_SCHED
}

typedef f32x4 Acc[2][2][4][2];

struct EpiP1 {
    bf16_t *QA, *G, *VT; const float *GN, *bgate;
    __device__ __forceinline__ void operator()(Acc& acc, const Unit& u, int wr, int wc, int fr, int fq, LAS float* scr) const {
        const int colw = 64 * wc + 8 * fq, rowl = wr * 64 + fr;
        if (u.sel == 1) {
            const int tok0 = u.pn * BM + colw;
#pragma unroll
            for (int ai = 0; ai < 2; ++ai)
#pragma unroll
                for (int m = 0; m < 4; ++m) { const int vd = u.pm * BM + rowl + ai * HALF + m * 16;
#pragma unroll
                    for (int bj = 0; bj < 2; ++bj) { const int tok = tok0 + 32 * bj;
                        *(u32x4*)(VT + ((size_t)((vd >> 7) * 128 + (tok >> 6)) * 8192 + (vd & 127) * 64 + (tok & 63))) = pack8(acc[ai][bj][m][0], acc[ai][bj][m][1]); } }
            return;
        }
        if (u.pn >= 16) {
            const int gcol = (u.pn - 16) * BM + colw;
            f32x4 bv[2][2];
#pragma unroll
            for (int bj = 0; bj < 2; ++bj)
#pragma unroll
                for (int n = 0; n < 2; ++n) bv[bj][n] = *(const f32x4*)(bgate + gcol + 32 * bj + 4 * n);
            bf16_t* base = G + (size_t)(u.pm * BM + rowl) * 4096 + gcol;
#pragma unroll
            for (int ai = 0; ai < 2; ++ai)
#pragma unroll
                for (int m = 0; m < 4; ++m) { bf16_t* rp = base + (size_t)(ai * HALF + m * 16) * 4096;
#pragma unroll
                    for (int bj = 0; bj < 2; ++bj) { f32x4 v[2];
#pragma unroll
                        for (int n = 0; n < 2; ++n)
#pragma unroll
                            for (int j = 0; j < 4; ++j) { const float z = acc[ai][bj][m][n][j] + bv[bj][n][j]; v[n][j] = fast_rcp(1.f + fast_exp2(-z * LOG2E)); }
                        *(u32x4*)(rp + 32 * bj) = pack8(v[0], v[1]); } }
            return;
        }
        const int t = u.pn >> 2; const bool fox = t >= 2;
        bf16_t* O = QA + (size_t)t * (8u << 20);
        const float* gn = GN + t * 128;
        const int d0 = (fox ? 64 * (wc & 1) : 0) + 8 * fq;
        f32x4 gv[2][2];
#pragma unroll
        for (int bj = 0; bj < 2; ++bj)
#pragma unroll
            for (int n = 0; n < 2; ++n) gv[bj][n] = *(const f32x4*)(gn + d0 + 32 * bj + 4 * n);
        float ss[2][4];
#pragma unroll
        for (int ai = 0; ai < 2; ++ai)
#pragma unroll
            for (int m = 0; m < 4; ++m) { float s = 0.f;
#pragma unroll
                for (int bj = 0; bj < 2; ++bj)
#pragma unroll
                    for (int n = 0; n < 2; ++n) { const f32x4 x = acc[ai][bj][m][n]; s += (x[0] * x[0] + x[1] * x[1]) + (x[2] * x[2] + x[3] * x[3]); }
                s += __shfl_xor(s, 16); s += __shfl_xor(s, 32); ss[ai][m] = s; }
        if (fox) {
            if (fq == 0) {
#pragma unroll
                for (int ai = 0; ai < 2; ++ai)
#pragma unroll
                    for (int m = 0; m < 4; ++m) scr[(ai * HALF + rowl + m * 16) * 4 + wc] = ss[ai][m];
            }
            LDS_WAIT(); __builtin_amdgcn_s_barrier(); asm volatile("" ::: "memory");
#pragma unroll
            for (int ai = 0; ai < 2; ++ai)
#pragma unroll
                for (int m = 0; m < 4; ++m) ss[ai][m] += scr[(ai * HALF + rowl + m * 16) * 4 + (wc ^ 1)];
            LDS_WAIT();
        }
        const float inv = fox ? (1.f / 128.f) : (1.f / 64.f);
        const bool isk = (t & 1) != 0; const int wsh = fox ? 7 : 6;
#pragma unroll
        for (int ai = 0; ai < 2; ++ai)
#pragma unroll
            for (int m = 0; m < 4; ++m) { const float rinv = fast_rsq(ss[ai][m] * inv + EPS); const int tok = u.pm * BM + rowl + ai * HALF + m * 16;
#pragma unroll
                for (int bj = 0; bj < 2; ++bj) { const f32x4 v0 = acc[ai][bj][m][0] * rinv * gv[bj][0], v1 = acc[ai][bj][m][1] * rinv * gv[bj][1];
                    const int col = (u.pn & 3) * BM + colw + 32 * bj;
                    const size_t off = isk ? ((size_t)((col >> wsh) * 128 + (tok >> 6)) << (6 + wsh)) + ((tok & 63) << wsh) + (col & ((1 << wsh) - 1)) : (size_t)tok * 1024 + col;
                    *(u32x4*)(O + off) = pack8(v0, v1); } }
    }
};

struct EpiP3 {
    const bf16_t* G; bf16_t* MGT; bf16_t* MG;
    __device__ __forceinline__ void operator()(Acc& acc, const Unit& u, int wr, int wc, int fr, int fq, LAS float*) const {
        const int col = u.pn * BM + 64 * wc + 8 * fq, row0 = u.pm * BM + wr * 64 + fr;
#pragma unroll
        for (int ai = 0; ai < 2; ++ai)
#pragma unroll
            for (int m = 0; m < 4; ++m) { const size_t row = (size_t)(row0 + ai * HALF + m * 16);
#pragma unroll
                for (int bj = 0; bj < 2; ++bj) { const int c = col + 32 * bj;
                    const u32x4 gw = *(const u32x4*)(G + row * 4096 + (u.sel ? 2048 : 0) + c);
                    const f32x4 g0 = {bf_lo(gw.x), bf_hi(gw.x), bf_lo(gw.y), bf_hi(gw.y)}, g1 = {bf_lo(gw.z), bf_hi(gw.z), bf_lo(gw.w), bf_hi(gw.w)};
                    f32x4 v0 = acc[ai][bj][m][0] * g0, v1 = acc[ai][bj][m][1] * g1;
                    bf16_t* tp = MGT + row * DM + c;
                    if (u.sel == 0) { *(u32x4*)tp = pack8(v0, v1); }
                    else { const u32x4 tw = *(const u32x4*)tp;
                        v0 += (f32x4){bf_lo(tw.x), bf_hi(tw.x), bf_lo(tw.y), bf_hi(tw.y)}; v1 += (f32x4){bf_lo(tw.z), bf_hi(tw.z), bf_lo(tw.w), bf_hi(tw.w)};
                        *(u32x4*)(MG + row * DM + c) = pack8(v0, v1); } } }
    }
};

struct EpiP4 {
    const float* x; bf16_t* X1B; float* SS2;
    __device__ __forceinline__ void operator()(Acc& acc, const Unit& u, int wr, int wc, int fr, int fq, LAS float*) const {
        const int col = u.pn * BM + 64 * wc + 8 * fq, row0 = u.pm * BM + wr * 64 + fr;
#pragma unroll
        for (int ai = 0; ai < 2; ++ai)
#pragma unroll
            for (int m = 0; m < 4; ++m) { const size_t row = (size_t)(row0 + ai * HALF + m * 16); float s = 0.f;
#pragma unroll
                for (int bj = 0; bj < 2; ++bj) { const size_t o = row * DM + col + 32 * bj;
                    const f32x4 v0 = acc[ai][bj][m][0] + *(const f32x4*)(x + o), v1 = acc[ai][bj][m][1] + *(const f32x4*)(x + o + 4);
                    *(u32x4*)(X1B + o) = pack8(v0, v1);
                    s += (v0[0] * v0[0] + v0[1] * v0[1]) + (v0[2] * v0[2] + v0[3] * v0[3]) + (v1[0] * v1[0] + v1[1] * v1[1]) + (v1[2] * v1[2] + v1[3] * v1[3]); }
                s += __shfl_xor(s, 16); s += __shfl_xor(s, 32);
                if (fq == 0) SS2[row * 32 + u.pn * 4 + wc] = s; }
    }
};

struct EpiP5 {
    const float* SS2; bf16_t* U; int pm0;
    __device__ __forceinline__ void operator()(Acc& acc, const Unit& u, int wr, int wc, int fr, int fq, LAS float* scr) const {
        const int col = u.pn * BM + 64 * wc + 8 * fq, row0 = u.pm * BM + wr * 64 + fr;
#pragma unroll
        for (int ai = 0; ai < 2; ++ai)
#pragma unroll
            for (int m = 0; m < 4; ++m) { const size_t row = (size_t)(row0 + ai * HALF + m * 16);
                float rinv;
                if (u.pm == pm0) rinv = scr[wr * 64 + fr + ai * HALF + m * 16];
                else { const f32x4* sp = (const f32x4*)(SS2 + row * 32); f32x4 sa = sp[0];
#pragma unroll
                    for (int q = 1; q < 8; ++q) sa += sp[q];
                    rinv = fast_rsq(((sa[0] + sa[1]) + (sa[2] + sa[3])) * (1.f / DM) + EPS); }
#pragma unroll
                for (int bj = 0; bj < 2; ++bj) { f32x4 v[2];
#pragma unroll
                    for (int n = 0; n < 2; ++n)
#pragma unroll
                        for (int j = 0; j < 4; ++j) { const float z = fmaxf(acc[ai][bj][m][n][j] * rinv, 0.f); v[n][j] = z * z; }
                    *(u32x4*)(U + row * FF + col + 32 * bj) = pack8(v[0], v[1]); } }
    }
};

struct EpiP6 {
    const bf16_t* X1B; float* out;
    __device__ __forceinline__ void operator()(Acc& acc, const Unit& u, int wr, int wc, int fr, int fq, LAS float*) const {
        const int col = u.pn * BM + 64 * wc + 8 * fq, row0 = u.pm * BM + wr * 64 + fr;
#pragma unroll
        for (int ai = 0; ai < 2; ++ai)
#pragma unroll
            for (int m = 0; m < 4; ++m) { const size_t row = (size_t)(row0 + ai * HALF + m * 16);
#pragma unroll
                for (int bj = 0; bj < 2; ++bj) { const size_t o = row * DM + col + 32 * bj; const u32x4 xw = *(const u32x4*)(X1B + o);
                    const f32x4 v0 = acc[ai][bj][m][0] + (f32x4){bf_lo(xw.x), bf_hi(xw.x), bf_lo(xw.y), bf_hi(xw.y)}, v1 = acc[ai][bj][m][1] + (f32x4){bf_lo(xw.z), bf_hi(xw.z), bf_lo(xw.w), bf_hi(xw.w)};
                    *(f32x4*)(out + o) = v0; *(f32x4*)(out + o + 4) = v1; } }
    }
};
}

__device__ __forceinline__ void transpose_item(const float* __restrict__ W, int ld, int col0, int ncols, int K, bf16_t* WT, int row_off, LAS float* scr, int item, int lane) {
    const int nblk = ncols / 32, kb = item / nblk, nb = item % nblk, k0 = 64 * kb, n0 = 32 * nb;
    const float* wp = W + (size_t)(k0 + (lane >> 5)) * ld + col0 + n0 + (lane & 31);
    LAS float* sp = scr + (lane >> 5) * 33 + (lane & 31);
#pragma unroll 4
    for (int i = 0; i < 32; ++i) { sp[i * 66] = *wp; wp += 2 * ld; }
    LDS_WAIT();
    const int c = lane & 7;
#pragma unroll
    for (int j = 0; j < 4; ++j) { const int n = (lane >> 3) + 8 * j; const LAS float* s = scr + (8 * c) * 33 + n;
        u32x4 o; o.x = cvt_pk_bf16(s[0 * 33], s[1 * 33]); o.y = cvt_pk_bf16(s[2 * 33], s[3 * 33]); o.z = cvt_pk_bf16(s[4 * 33], s[5 * 33]); o.w = cvt_pk_bf16(s[6 * 33], s[7 * 33]);
        *(u32x4*)(WT + (size_t)(row_off + n0 + n) * K + k0 + 8 * c) = o; }
    LDS_WAIT();
}

__device__ __forceinline__ void transpose_item64(const float* __restrict__ W, int ld, int ncols, int K, bf16_t* WT, LAS float* scr, int item, int lane, const float* ks = nullptr) {
    const int nblk = ncols / 64, kb = item / nblk, nb = item % nblk, k0 = 64 * kb, n0 = 64 * nb;
    const float* wp = W + (size_t)(k0 + (lane >> 4)) * ld + n0 + 4 * (lane & 15);
    f32x4 v[16];
#pragma unroll
    for (int i = 0; i < 16; ++i) v[i] = *(const f32x4*)(wp + (size_t)(4 * i) * ld);
    if (ks) {
#pragma unroll
        for (int i = 0; i < 16; ++i) v[i] = v[i] * ks[k0 + 4 * i + (lane >> 4)]; }
    LAS float* sp = scr + (lane >> 4) * 65 + 4 * (lane & 15);
#pragma unroll
    for (int i = 0; i < 16; ++i) { sp[(4 * i) * 65 + 0] = v[i][0]; sp[(4 * i) * 65 + 1] = v[i][1]; sp[(4 * i) * 65 + 2] = v[i][2]; sp[(4 * i) * 65 + 3] = v[i][3]; }
    LDS_WAIT();
    const int c = lane >> 3;
#pragma unroll
    for (int j = 0; j < 8; ++j) { const int n = (lane & 7) + 8 * j; const LAS float* s = scr + (8 * c) * 65 + n;
        u32x4 o; o.x = cvt_pk_bf16(s[0 * 65], s[1 * 65]); o.y = cvt_pk_bf16(s[2 * 65], s[3 * 65]); o.z = cvt_pk_bf16(s[4 * 65], s[5 * 65]); o.w = cvt_pk_bf16(s[6 * 65], s[7 * 65]);
        *(u32x4*)(WT + (size_t)(n0 + n) * K + k0 + 8 * c) = o; }
    LDS_WAIT();
}

namespace att {
constexpr int VROW = 144, BUF = 36864;
static_assert(2 * BUF <= GEMM_LDS, "attention LDS map");
#define MFMA32(a, b, c) __builtin_amdgcn_mfma_f32_32x32x16_bf16((a), (b), (c), 0, 0, 0)

__device__ __forceinline__ void pack_p(const f32x16& S, bf16x8 (&pf)[2]) {
#pragma unroll
    for (int s = 0; s < 2; ++s) { u32x4 p; p.x = cvt_pk_bf16(S[8 * s + 0], S[8 * s + 1]); p.y = cvt_pk_bf16(S[8 * s + 2], S[8 * s + 3]); p.z = cvt_pk_bf16(S[8 * s + 4], S[8 * s + 5]); p.w = cvt_pk_bf16(S[8 * s + 6], S[8 * s + 7]);
        pf[s] = __builtin_bit_cast(bf16x8, p); }
}
constexpr float PRUNE_THR = 80.f;
template <bool DIFF>
__device__ __forceinline__ void attn_unit(LAS unsigned char* lds, const bf16_t* __restrict__ Q, const bf16_t* __restrict__ Kg, const bf16_t* __restrict__ Vt, const float* __restrict__ c2g,
                                          bf16_t* Og, float* park, int head, int qb, int mp, float lam, const float* GN, const bool both = false, bf16_t* OAf = nullptr, const float* subln = nullptr) {
    constexpr int NX = DIFF ? 4 : 8, KROW = DIFF ? 144 : 272, V_OFF = 64 * KROW, C2_OFF = V_OFF + 128 * VROW;
    static_assert(C2_OFF + 256 <= BUF, "attention buffer");
    const int tid = threadIdx.x, lane = tid & 63, w = __builtin_amdgcn_readfirstlane(tid >> 6), r = lane & 31, h = lane >> 5;
    const int trow = qb * 256 + 32 * w + r;
    const int jmax = 4 * qb + 3, jd = 4 * qb + (w >> 1);
    const int toff = 32 * (w & 1) + r;
    const float slope2 = DIFF ? exp2f(-(float)(head + 1)) * LOG2E : 0.f;
    const bf16_t* gV = Vt + (size_t)head * 128 * 8192 + tid * 8;
    const unsigned lV = V_OFF + (tid >> 3) * VROW + (tid & 7) * 16;
    const unsigned lK = DIFF ? (tid >> 3) * KROW + (tid & 7) * 16 : (tid >> 4) * KROW + (tid & 15) * 16;
    const int kap = (r & ~12) | ((r & 4) << 1) | ((r & 8) >> 1);
    const unsigned rK = kap * KROW + 16 * h, rV = V_OFF + r * VROW + 16 * h;
    f32x16 O[4];
    int jmin = 0;
    if (DIFF) {
        float gq = fabsf(GN[lane]), gk = fabsf(GN[128 + lane]);
#pragma unroll
        for (int o = 1; o < 64; o <<= 1) { gq = fmaxf(gq, __shfl_xor(gq, o)); gk = fmaxf(gk, __shfl_xor(gk, o)); }
        const float B2 = 2.f * 1.05f * 64.f * gq * gk;
        const float dmax = (PRUNE_THR + B2) / slope2;
        const float jf = ceilf(((float)(256 * qb - 63) - dmax) * (1.f / 64.f));
        jmin = jf > 0.f ? (int)jf : 0;
    } else {
        float gq = fmaxf(fabsf(GN[256 + lane]), fabsf(GN[320 + lane])), gk = fmaxf(fabsf(GN[384 + lane]), fabsf(GN[448 + lane]));
#pragma unroll
        for (int o = 1; o < 64; o <<= 1) { gq = fmaxf(gq, __shfl_xor(gq, o)); gk = fmaxf(gk, __shfl_xor(gk, o)); }
        const float B2 = 2.f * 1.05f * 128.f * gq * gk;
        const float cref = c2g[head * SEQ + 256 * qb];
        const int j0 = lane, j1 = lane + 64;
        const bool n0 = (j0 <= jmax) && (B2 + c2g[head * SEQ + 64 * (j0 <= jmax ? j0 : 0) + 63] - cref >= -PRUNE_THR);
        const bool n1 = (j1 <= jmax) && (B2 + c2g[head * SEQ + 64 * (j1 <= jmax ? j1 : 0) + 63] - cref >= -PRUNE_THR);
        const unsigned long long b0 = __ballot(n0), b1 = __ballot(n1);
        jmin = b0 ? (__ffsll((long long)b0) - 1) : (b1 ? 64 + __ffsll((long long)b1) - 1 : 4 * qb);
        if (jmin > 4 * qb) jmin = 4 * qb;
    }
    jmin = __builtin_amdgcn_readfirstlane(jmin);
#pragma unroll 1
    for (int pass = 0; pass < (DIFF && both ? 2 : 1); ++pass) {
        const int mpc = (DIFF && both) ? pass : mp;
        bf16x8 qf[NX];
        { const bf16_t* qp = Q + (size_t)trow * 1024 + head * 128 + (DIFF ? 64 * mpc : 0) + 8 * h;
#pragma unroll
          for (int x = 0; x < NX; ++x) qf[x] = *(const bf16x8*)(qp + 16 * x);
#pragma unroll
          for (int x = 0; x < NX; ++x) asm volatile("" : "+v"(qf[x])); }
        const bf16_t* gK = DIFF ? Kg + (size_t)(head * 2 + mpc) * 128 * 4096 + tid * 8 : Kg + (size_t)head * 128 * 8192 + tid * 8;
        u32x4 kreg[2], vreg[2]; float creg = 0.f;
#define ATT_LOAD(j) do { const size_t j_ = (size_t)(j); kreg[0] = *(const u32x4*)(gK + j_ * (DIFF ? 4096 : 8192)); if (!DIFF) kreg[1] = *(const u32x4*)(gK + j_ * 8192 + 4096); \
        vreg[0] = *(const u32x4*)(gV + j_ * 8192); vreg[1] = *(const u32x4*)(gV + j_ * 8192 + 4096); if (!DIFF && tid < 64) creg = c2g[head * SEQ + j_ * 64 + tid]; } while (0)
#define ATT_WRITE(b) do { LAS unsigned char* bp_ = lds + (b) * BUF; *(LAS u32x4*)(bp_ + lK) = kreg[0]; if (!DIFF) *(LAS u32x4*)(bp_ + lK + 32 * KROW) = kreg[1]; \
        *(LAS u32x4*)(bp_ + lV) = vreg[0]; *(LAS u32x4*)(bp_ + lV + 64 * VROW) = vreg[1]; if (!DIFF && tid < 64) *(LAS float*)(bp_ + C2_OFF + tid * 4) = creg; } while (0)
#pragma unroll
        for (int db = 0; db < 4; ++db)
#pragma unroll
            for (int i = 0; i < 16; ++i) O[db][i] = 0.f;
        float m = DIFF ? slope2 * (float)toff : c2g[head * SEQ + trow], l = 0.f;
        asm volatile("" : "+v"(m));
        ATT_LOAD(jmax); ATT_WRITE(0);
        __syncthreads();
        int cur = 0;
        for (int j = jmax; j >= jmin; --j) {
            if (j > jd) { if (j > jmin) ATT_LOAD(j - 1); }
            if (j <= jd) {
                const bool diag = (j == jd);
                const LAS unsigned char* bp = lds + cur * BUF;
                if (__any(l > 1.8446744e19f)) {
                    const float a = 5.421010862e-20f; l *= a; m += 64.f;
#pragma unroll
                    for (int db = 0; db < 4; ++db) O[db] *= a;
                }
                if (DIFF && !diag) m += 64.f * slope2;
                f32x16 S0, S1;
                bf16x8 kfa[NX], kfb[DIFF ? NX : 1];
#pragma unroll
                for (int x = 0; x < NX; ++x) { kfa[x] = *(const LAS bf16x8*)(bp + rK + x * 32); if (DIFF) kfb[x] = *(const LAS bf16x8*)(bp + rK + 32 * KROW + x * 32); }
                asm volatile("" ::: "memory");
                if (DIFF) {
                    if (diag) { int toff_v = toff, h_v = 8 * h; asm volatile("" : "+v"(toff_v), "+v"(h_v)); const float tf = (float)toff_v, hf = (float)h_v, base = slope2 * tf - m;
#pragma unroll
                        for (int i = 0; i < 16; ++i) { const float ko = (float)(16 * (i >> 3) + (i & 7)) + hf; S0[i] = base - slope2 * fabsf(ko - tf); S1[i] = base - slope2 * fabsf(ko + 32.f - tf); } }
                    else { const float base = slope2 * (float)(8 * h) - m;
#pragma unroll
                        for (int i = 0; i < 16; ++i) { S0[i] = fmaf(slope2, (float)(16 * (i >> 3) + (i & 7)), base); S1[i] = fmaf(slope2, (float)(32 + 16 * (i >> 3) + (i & 7)), base); } }
                } else {
                    const LAS f32x4* cp = (const LAS f32x4*)(bp + C2_OFF + (8 * h) * 4);
                    const f32x4 c0 = cp[0], c1 = cp[1], c2v = cp[4], c3 = cp[5], d0 = cp[8], d1 = cp[9], d2 = cp[12], d3 = cp[13];
#pragma unroll
                    for (int i = 0; i < 4; ++i) { S0[i] = c0[i] - m; S0[4 + i] = c1[i] - m; S0[8 + i] = c2v[i] - m; S0[12 + i] = c3[i] - m;
                                                  S1[i] = d0[i] - m; S1[4 + i] = d1[i] - m; S1[8 + i] = d2[i] - m; S1[12 + i] = d3[i] - m; }
                }
                __builtin_amdgcn_s_setprio(2);
                if (DIFF) {
#pragma unroll
                    for (int x = 0; x < NX; ++x) { S0 = MFMA32(kfa[x], qf[x], S0); S1 = MFMA32(kfb[x], qf[x], S1); }
                } else {
#pragma unroll
                    for (int x = 0; x < NX; ++x) S0 = MFMA32(kfa[x], qf[x], S0);
#pragma unroll
                    for (int x = 0; x < NX; ++x) kfa[x] = *(const LAS bf16x8*)(bp + rK + 32 * KROW + x * 32);
                    asm volatile("" ::: "memory");
#pragma unroll
                    for (int x = 0; x < NX; ++x) S1 = MFMA32(kfa[x], qf[x], S1);
                }
                if (j > jmin) ATT_LOAD(j - 1);
                bf16x8 vf0[8], vf1[8];
#pragma unroll
                for (int s = 0; s < 2; ++s)
#pragma unroll
                    for (int db = 0; db < 4; ++db) vf0[s * 4 + db] = *(const LAS bf16x8*)(bp + rV + db * 32 * VROW + s * 32);
                asm volatile("" ::: "memory");
                if (diag) {
                    if (!DIFF) { int toff_v = toff - 8 * h; asm volatile("" : "+v"(toff_v));
#pragma unroll
                        for (int i = 0; i < 16; ++i) { const int ko = 16 * (i >> 3) + (i & 7); if (ko > toff_v) S0[i] = -INFINITY; if (ko + 32 > toff_v) S1[i] = -INFINITY; } }
                    float tm = S0[0];
#pragma unroll
                    for (int i = 1; i < 16; ++i) tm = fmaxf(tm, S0[i]);
#pragma unroll
                    for (int i = 0; i < 16; ++i) tm = fmaxf(tm, S1[i]);
                    tm = fmaxf(tm, __shfl_xor(tm, 32));
                    m += tm;
#pragma unroll
                    for (int i = 0; i < 16; ++i) { S0[i] -= tm; S1[i] -= tm; }
                }
                bf16x8 pf0[2], pf1[2];
                float ls = 0.f;
#pragma unroll
                for (int i = 0; i < 16; ++i) { S0[i] = fast_exp2(S0[i]); ls += S0[i]; }
                pack_p(S0, pf0);
#pragma unroll
                for (int s = 0; s < 2; ++s)
#pragma unroll
                    for (int db = 0; db < 4; ++db) O[db] = MFMA32(vf0[s * 4 + db], pf0[s], O[db]);
#pragma unroll
                for (int s = 0; s < 2; ++s)
#pragma unroll
                    for (int db = 0; db < 4; ++db) vf1[s * 4 + db] = *(const LAS bf16x8*)(bp + rV + db * 32 * VROW + 64 + s * 32);
                asm volatile("" ::: "memory");
#pragma unroll
                for (int i = 0; i < 16; ++i) { S1[i] = fast_exp2(S1[i]); ls += S1[i]; }
                pack_p(S1, pf1);
                l += ls;
#pragma unroll
                for (int s = 0; s < 2; ++s)
#pragma unroll
                    for (int db = 0; db < 4; ++db) O[db] = MFMA32(vf1[s * 4 + db], pf1[s], O[db]);
                __builtin_amdgcn_s_setprio(0);
            }
            if (j > jmin) ATT_WRITE(cur ^ 1);
            __syncthreads();
            cur ^= 1;
        }
        l += __shfl_xor(l, 32);
        const float il = (DIFF && mpc == 1) ? -lam / l : 1.f / l;
#pragma unroll
        for (int db = 0; db < 4; ++db) O[db] *= il;
        if (DIFF && both) {
            float* pk = park + tid * 64;
            if (pass == 0) {
#pragma unroll
                for (int db = 0; db < 4; ++db)
#pragma unroll
                    for (int g = 0; g < 4; ++g) *(f32x4*)(pk + db * 16 + 4 * g) = (f32x4){O[db][4 * g], O[db][4 * g + 1], O[db][4 * g + 2], O[db][4 * g + 3]};
            } else {
#pragma unroll
                for (int db = 0; db < 4; ++db)
#pragma unroll
                    for (int g = 0; g < 4; ++g) { const f32x4 pv = *(const f32x4*)(pk + db * 16 + 4 * g);
#pragma unroll
                        for (int i = 0; i < 4; ++i) O[db][4 * g + i] += pv[i]; }
            }
        }
#undef ATT_LOAD
#undef ATT_WRITE
    }
    asm volatile("" ::: "memory");
    if (DIFF && both) {
        float ss = 0.f;
#pragma unroll
        for (int db = 0; db < 4; ++db)
#pragma unroll
            for (int i = 0; i < 16; ++i) ss += O[db][i] * O[db][i];
        ss += __shfl_xor(ss, 32);
        const float rinv = fast_rsq(ss * (1.f / 128.f) + EPS) * 0.8f;
#pragma unroll
        for (int db = 0; db < 4; ++db)
#pragma unroll
            for (int g = 0; g < 4; ++g) { const f32x4 sgv = *(const f32x4*)(subln + 32 * db + 8 * g + 4 * h);
#pragma unroll
                for (int i = 0; i < 4; ++i) O[db][4 * g + i] *= rinv * sgv[i]; }
    }
    bf16_t* op = ((DIFF && both) ? OAf : Og + (DIFF ? (size_t)mp * ((size_t)SEQ * 1024) : (size_t)0)) + (size_t)trow * 1024 + head * 128 + 4 * h;
#pragma unroll
    for (int db = 0; db < 4; ++db)
#pragma unroll
        for (int g = 0; g < 4; ++g) { u32x2 o; o.x = cvt_pk_bf16(O[db][4 * g], O[db][4 * g + 1]); o.y = cvt_pk_bf16(O[db][4 * g + 2], O[db][4 * g + 3]);
            *(u32x2*)(op + 32 * db + 8 * g) = o; }
}
}

#define XB_TMO      128
#define XB_XCNT(j)  (256  + 64 * (j))
#define XB_XSUB(j)  (1280 + 64 * (j))
#define XB_XGEN(j)  (2304 + 64 * (j))
#define XB_TOP      3328
#define XB_TOPGEN   3392
#define XCD_BAR_WORDS 3456
#define XB_SPIN_CAP (1u << 22)
__device__ __forceinline__ unsigned xb_ld(unsigned* p)              { return __hip_atomic_load(p, __ATOMIC_RELAXED, __HIP_MEMORY_SCOPE_AGENT); }
__device__ __forceinline__ unsigned xb_add(unsigned* p, unsigned v) { return __hip_atomic_fetch_add(p, v, __ATOMIC_RELAXED, __HIP_MEMORY_SCOPE_AGENT); }
__device__ __forceinline__ unsigned xb_xcc_id() { return (unsigned)__builtin_amdgcn_s_getreg((3 << 11) | 20) & 0xFu; }
#define XB_SPIN(cond, bar) do { unsigned _sp = 0; while (cond) { __builtin_amdgcn_s_sleep(1); \
    if ((++_sp & 255u) == 0u) { if (xb_ld(&(bar)[XB_TMO])) break; if (_sp > XB_SPIN_CAP) { atomicAdd(&(bar)[XB_TMO], 1u); break; } } } } while (0)
struct XcdBarrier { unsigned* bar; unsigned x; volatile LAS unsigned* st; };
__device__ __forceinline__ XcdBarrier xcd_barrier_post(unsigned* bar, volatile LAS unsigned* st) {
    XcdBarrier b; b.bar = bar; b.x = xb_xcc_id(); b.st = st;
    if (threadIdx.x == 0) (void)xb_add(&bar[XB_XCNT(b.x)], 1u);
    return b;
}
__device__ __forceinline__ void xcd_barrier_complete(unsigned* bar, unsigned x, unsigned& nloc, unsigned& nx) {
    const unsigned G = gridDim.x * gridDim.y * gridDim.z;
    unsigned sum, cnt, mine, sp = 0u;
    for (;;) {
        sum = 0u; cnt = 0u; mine = 0u;
#pragma unroll
        for (unsigned j = 0; j < 16; ++j) { const unsigned c = xb_ld(&bar[XB_XCNT(j)]); sum += c; cnt += (c > 0u) ? 1u : 0u; mine = (j == x) ? c : mine; }
        if (sum == G) break;
        __builtin_amdgcn_s_sleep(1);
        if ((++sp & 255u) == 0u) { if (xb_ld(&bar[XB_TMO])) break; if (sp > XB_SPIN_CAP) { atomicAdd(&bar[XB_TMO], 1u); break; } }
    }
    nloc = mine > 0u ? mine : 1u; nx = cnt > 0u ? cnt : 1u;
}
__device__ __forceinline__ void xcd_barrier(const XcdBarrier& b) {
    asm volatile("s_waitcnt vmcnt(0)" ::: "memory");
    __syncthreads();
    if (threadIdx.x == 0) {
        unsigned* bar = b.bar;
        __builtin_amdgcn_s_waitcnt(0);
        unsigned nloc = b.st[0], nx = b.st[1];
        if (nloc == 0u) { xcd_barrier_complete(bar, b.x, nloc, nx); b.st[0] = nloc; b.st[1] = nx; }
        const unsigned k = b.st[2]; b.st[2] = k + 1u;
        const unsigned old = xb_add(&bar[XB_XSUB(b.x)], 1u);
        const unsigned gen = old / nloc;
        if (old + 1u == (gen + 1u) * nloc) {
            __builtin_amdgcn_fence(__ATOMIC_RELEASE, "agent");
            asm volatile("s_waitcnt vmcnt(0)" ::: "memory");
            const unsigned og = xb_add(&bar[XB_TOP], 1u);
            const unsigned tg = og / nx;
            if (og + 1u == (tg + 1u) * nx) xb_add(&bar[XB_TOPGEN], 1u);
        }
        XB_SPIN(xb_ld(&bar[XB_TOPGEN]) == k, bar);
        __builtin_amdgcn_fence(__ATOMIC_ACQUIRE, "agent");
        asm volatile("s_waitcnt vmcnt(0)" ::: "memory");
    }
    __syncthreads();
}

struct Args { const float* in[21]; float* out; unsigned char* ws; int ph_lo, ph_hi, att_sel, pad; };

__global__ void __launch_bounds__(NTHREADS, 2) fwd_kernel(Args args) {
    extern __shared__ __attribute__((aligned(16))) unsigned char lds_raw[];
    LAS unsigned char* lds = (LAS unsigned char*)lds_raw;
    const int tid = threadIdx.x, lane = tid & 63, wave = __builtin_amdgcn_readfirstlane(tid >> 6);
    const int G = gridDim.x, bx = blockIdx.x;
    const int vcu = (G % 8 == 0) ? (bx % 8) * (G / 8) + bx / 8 : bx;
    unsigned char* ws = args.ws;
    const float* x = args.in[0];       const float* norm_mix = args.in[1]; const float* w_in = args.in[2];   const float* b_forget = args.in[3];
    const float* qn_diff = args.in[4]; const float* kn_diff = args.in[5];  const float* lq1 = args.in[6];    const float* lk1 = args.in[7];
    const float* lq2 = args.in[8];     const float* lk2 = args.in[9];      const float* subln = args.in[10]; const float* qn_fox = args.in[11];
    const float* kn_fox = args.in[12]; const float* w_bd = args.in[13];    const float* w_bf = args.in[14];  const float* w_gate = args.in[15];
    const float* b_gate = args.in[16]; const float* w_out = args.in[17];   const float* norm_mlp = args.in[18]; const float* w_up = args.in[19];
    const float* w_down = args.in[20];
    float* out = args.out;
    float* LF = (float*)(ws + WS_LF); float* C2 = (float*)(ws + WS_C2); float* SS2 = (float*)(ws + WS_SS2); float* GN = (float*)(ws + WS_GN);
    bf16_t *Wbd = (bf16_t*)(ws + WS_WBD), *Wbf = (bf16_t*)(ws + WS_WBF), *Wout = (bf16_t*)(ws + WS_WOUT), *Wt1 = (bf16_t*)(ws + WS_WT1), *Wt2 = (bf16_t*)(ws + WS_WT2);
    bf16_t *Wup = (bf16_t*)(ws + WS_WUP), *Wdown = (bf16_t*)(ws + WS_WDOWN), *H = (bf16_t*)(ws + WS_H);
    bf16_t *QA = (bf16_t*)(ws + WS_QA), *KA = (bf16_t*)(ws + WS_KA), *QB = (bf16_t*)(ws + WS_QB), *KB = (bf16_t*)(ws + WS_KB), *VT = (bf16_t*)(ws + WS_VT);
    bf16_t *Gt = (bf16_t*)(ws + WS_G), *OA = (bf16_t*)(ws + WS_OA), *OB = (bf16_t*)(ws + WS_OB), *MG = (bf16_t*)(ws + WS_MG), *XG = (bf16_t*)(ws + WS_XG), *U = (bf16_t*)(ws + WS_U);
    bf16_t* MGT = (bf16_t*)(ws + WS_MGT);
    const int lo = args.ph_lo, hi = args.ph_hi;
    const int gw = vcu * NWAVES + wave, NGW = G * NWAVES;
#ifndef PH_MASK
#define PH_MASK 0xff
#endif
#define IN(k) (((PH_MASK >> (k)) & 1) && lo <= (k) && (k) < hi)
#define SEAM(k) do { if (IN(k) && IN((k) + 1)) { if (args.pad != 0) cg::this_grid().sync(); else xcd_barrier(xbar); } } while (0)
    XcdBarrier xbar; xbar.bar = (unsigned*)(ws + WS_CTL) + 1024; xbar.x = 0; xbar.st = (volatile LAS unsigned*)(lds + LDS_BAR_OFF);
    if (hi - lo > 1) {
        if (tid < 3) ((volatile LAS unsigned*)(lds + LDS_BAR_OFF))[tid] = 0u;
        __syncthreads();
        xbar = xcd_barrier_post((unsigned*)(ws + WS_CTL) + 1024, (volatile LAS unsigned*)(lds + LDS_BAR_OFF));
    }

    if (IN(0)) {
        LAS float* scr = (LAS float*)(lds + wave * P0_SCR_STRIDE);
        LAS float* wf = (LAS float*)(lds + P0_WF_OFF);
        if (bx == 0) { if (tid < 64) { GN[tid] = qn_diff[tid] * (0.125f * LOG2E); GN[128 + tid] = kn_diff[tid]; } if (tid < 128) { GN[256 + tid] = qn_fox[tid] * (0.08838834764831845f * LOG2E); GN[384 + tid] = kn_fox[tid]; } }
        for (int k = tid; k < DM; k += NTHREADS) { const f32x4 a = *(const f32x4*)(w_in + (size_t)k * NPROJ + 6144), b = *(const f32x4*)(w_in + (size_t)k * NPROJ + 6148);
            wf[0 * DM + k] = a[0]; wf[1 * DM + k] = a[1]; wf[2 * DM + k] = a[2]; wf[3 * DM + k] = a[3]; wf[4 * DM + k] = b[0]; wf[5 * DM + k] = b[1]; wf[6 * DM + k] = b[2]; wf[7 * DM + k] = b[3]; }
        __syncthreads();
        constexpr int I0 = 2048, I1 = 2048, I2 = 4096, I3 = 1024, I4 = 1024, NIT = I0 + I1 + I2 + I3 + I4;
        for (int it = gw; it < NIT; it += NGW) {
            int q = it;
            if (q < I0) { transpose_item(w_in, NPROJ, 0, 2048, DM, Wt1, 0, scr, q, lane); continue; } q -= I0;
            if (q < I1) { transpose_item(w_in, NPROJ, 3072, 2048, DM, Wt1, 2048, scr, q, lane); continue; } q -= I1;
            if (q < I2) { transpose_item(w_gate, 4096, 0, 4096, DM, Wt1, 4096, scr, q, lane); continue; } q -= I2;
            if (q < I3) { transpose_item(w_in, NPROJ, 2048, 1024, DM, Wt2, 0, scr, q, lane); continue; } q -= I3;
            transpose_item(w_in, NPROJ, 5120, 1024, DM, Wt2, 1024, scr, q, lane);
        }
        for (int row = gw; row < SEQ; row += NGW) {
            const f32x4* xr = (const f32x4*)(x + (size_t)row * DM) + lane;
            f32x4 v[8]; float s = 0.f;
#pragma unroll
            for (int j = 0; j < 8; ++j) { v[j] = xr[64 * j]; s += (v[j][0] * v[j][0] + v[j][1] * v[j][1]) + (v[j][2] * v[j][2] + v[j][3] * v[j][3]); }
            const float rinv = fast_rsq(wave_sum(s) * (1.f / DM) + EPS);
            float a0 = 0.f, a1 = 0.f, a2 = 0.f, a3 = 0.f, a4 = 0.f, a5 = 0.f, a6 = 0.f, a7 = 0.f;
            u32x2* hp = (u32x2*)(H + (size_t)row * DM) + lane;
#pragma unroll
            for (int j = 0; j < 8; ++j) { const f32x4 gg = ((const f32x4*)norm_mix)[lane + 64 * j]; const f32x4 hv = v[j] * rinv * gg;
                u32x2 o; o.x = cvt_pk_bf16(hv[0], hv[1]); o.y = cvt_pk_bf16(hv[2], hv[3]); hp[64 * j] = o;
                const LAS f32x4* wp = (const LAS f32x4*)wf + lane + 64 * j;
#define FDOT(acc_, jj) { const f32x4 w4 = wp[(jj) * (DM / 4)]; acc_ += (hv[0] * w4[0] + hv[1] * w4[1]) + (hv[2] * w4[2] + hv[3] * w4[3]); }
                FDOT(a0, 0) FDOT(a1, 1) FDOT(a2, 2) FDOT(a3, 3) FDOT(a4, 4) FDOT(a5, 5) FDOT(a6, 6) FDOT(a7, 7)
                asm volatile("" ::: "memory");
#undef FDOT
            }
            a0 = wave_sum(a0); a1 = wave_sum(a1); a2 = wave_sum(a2); a3 = wave_sum(a3); a4 = wave_sum(a4); a5 = wave_sum(a5); a6 = wave_sum(a6); a7 = wave_sum(a7);
            if (lane < 8) { float z = lane == 0 ? a0 : lane == 1 ? a1 : lane == 2 ? a2 : lane == 3 ? a3 : lane == 4 ? a4 : lane == 5 ? a5 : lane == 6 ? a6 : a7;
                z += b_forget[lane]; LF[(size_t)lane * SEQ + row] = fminf(z, 0.f) - log1pf(expf(-fabsf(z))); }
        }
        __syncthreads();
    }
    SEAM(0);

    if (IN(1)) {
        {
            pg8::Gemm g{H, Wt2, Wt1, H, DM};
            pg8::P1Order S{G, bx};
            pg8::EpiP1 E{QA, Gt, VT, GN, b_gate};
            pg8::gemm_phase(lds, g, S, E);
        }
        __syncthreads();
        if (bx < 8) {
            LAS double* wsum = (LAS double*)lds;
            const int j = bx; float vals[16]; double s = 0.0;
#pragma unroll
            for (int i = 0; i < 16; ++i) { vals[i] = LF[(size_t)j * SEQ + 16 * tid + i]; s += (double)vals[i]; }
            double inc = s;
#pragma unroll
            for (int o = 1; o < 64; o <<= 1) { const double t = __shfl_up(inc, o); if (lane >= o) inc += t; }
            if (lane == 63) wsum[wave] = inc;
            __syncthreads();
            double run = inc - s;
            for (int q = 0; q < wave; ++q) run += wsum[q];
#pragma unroll
            for (int i = 0; i < 16; ++i) { run += (double)vals[i]; C2[(size_t)j * SEQ + 16 * tid + i] = (float)(-run * (double)LOG2E); }
            __syncthreads();
        }
    }
    SEAM(1);

    if (IN(2)) {
        float lam;
        { const float p1 = wave_sum(lq1[lane] * lk1[lane]), p2 = wave_sum(lq2[lane] * lk2[lane]); lam = expf(p1) - expf(p2) + 0.2f; }
        unsigned* ctl = (unsigned*)(ws + WS_CTL);
        LAS unsigned* qh = (LAS unsigned*)(lds + 8 * 16640 + 64);
        constexpr int TR_IU = 32 * 128, TR_ID = 128 * 32, TR_IB = 16 * 32, TR_IO = 32 * 32, TR_NQ = TR_IU + TR_ID + 2 * TR_IB + TR_IO;
#define TR_ROUNDS(n) do { int lane_ = lane, wave_ = wave; asm volatile("" : "+v"(lane_), "+s"(wave_));     \
        LAS float* scr_ = (LAS float*)(lds + wave_ * 16640); LAS unsigned* qh2_ = (LAS unsigned*)(lds + 8 * 16640); \
        for (int rd_ = 0; rd_ < (n); ++rd_) { if (tid == 0) *qh2_ = atomicAdd(ctl + 0, (unsigned)NWAVES); __syncthreads(); const int it0_ = (int)*qh2_; __syncthreads(); if (it0_ >= TR_NQ) break; \
            int q_ = it0_ + wave_; \
            if (q_ < TR_NQ) { if (q_ < TR_IU) transpose_item64(w_up, FF, FF, DM, Wup, scr_, q_, lane_, norm_mlp);     \
                else if ((q_ -= TR_IU) < TR_ID) transpose_item64(w_down, DM, DM, FF, Wdown, scr_, q_, lane_); \
                else if ((q_ -= TR_ID) < TR_IB) transpose_item64(w_bd, DM, DM, 1024, Wbd, scr_, q_, lane_); \
                else if ((q_ -= TR_IB) < TR_IB) transpose_item64(w_bf, DM, DM, 1024, Wbf, scr_, q_, lane_); \
                else transpose_item64(w_out, DM, DM, DM, Wout, scr_, q_ - TR_IB, lane_); } } } while (0)
#define NEXT_JOB(word, step, dst) do { if (tid == 0) *qh = atomicAdd(ctl + (word), (unsigned)(step)); __syncthreads(); dst = (int)*qh; __syncthreads(); } while (0)
#ifndef ATT_SKIP_DIFF
        if (args.att_sel != 2) for (;;) {
            int job; NEXT_JOB(1, 1, job); if (job >= 512) break;
            const int qb = 31 - (job >> 4), r = job & 15;
            const bool both = r >= 6;
            if (both && (r & 1)) continue;
            att::attn_unit<true>(lds, QA, KA, VT, nullptr, (bf16_t*)out, out + (size_t)SEQ * 1024 + (size_t)bx * (64 * NTHREADS), 7 - (r >> 1), qb, r & 1, lam, GN, both, OA, subln);
            if (args.att_sel == 0) TR_ROUNDS(2);
        }
#endif
#ifndef ATT_SKIP_FOX
        if (args.att_sel != 1) for (;;) {
            int job; NEXT_JOB(2, 1, job); if (job >= 256) break;
            att::attn_unit<false>(lds, QB, KB, VT + (size_t)1024 * SEQ, C2, OB, nullptr, job & 7, 31 - (job >> 3), 0, 0.f, GN);
            if (args.att_sel == 0) TR_ROUNDS(1);
        }
#endif
        if (args.att_sel == 0) TR_ROUNDS(1 << 30);
#undef NEXT_JOB
#undef TR_ROUNDS
    }
    SEAM(2);

    if (IN(3)) {
        const bf16_t* o0 = (const bf16_t*)out; const bf16_t* o1 = o0 + (size_t)SEQ * 1024;
        f32x4 sg[4];
#pragma unroll
        for (int i = 0; i < 4; ++i) sg[i] = *(const f32x4*)(subln + (lane & 7) * 16 + 4 * i) * 0.8f;
        for (int row = gw; row < SEQ; row += NGW) {
            const size_t off = (size_t)row * 1024 + lane * 16;
            if (lane < 40) continue;
            f32x4 v[4]; float ss = 0.f;
#pragma unroll
            for (int i = 0; i < 2; ++i) { const u32x4 a = *(const u32x4*)(o0 + off + 8 * i), b = *(const u32x4*)(o1 + off + 8 * i);
                v[2 * i] = (f32x4){bf_lo(a.x) + bf_lo(b.x), bf_hi(a.x) + bf_hi(b.x), bf_lo(a.y) + bf_lo(b.y), bf_hi(a.y) + bf_hi(b.y)};
                v[2 * i + 1] = (f32x4){bf_lo(a.z) + bf_lo(b.z), bf_hi(a.z) + bf_hi(b.z), bf_lo(a.w) + bf_lo(b.w), bf_hi(a.w) + bf_hi(b.w)}; }
#pragma unroll
            for (int i = 0; i < 4; ++i) ss += (v[i][0] * v[i][0] + v[i][1] * v[i][1]) + (v[i][2] * v[i][2] + v[i][3] * v[i][3]);
            ss += __shfl_xor(ss, 1); ss += __shfl_xor(ss, 2); ss += __shfl_xor(ss, 4);
            const float rinv = fast_rsq(ss * (1.f / 128.f) + EPS);
#pragma unroll
            for (int i = 0; i < 4; ++i) v[i] = v[i] * rinv * sg[i];
            *(u32x4*)(OA + off) = pack8(v[0], v[1]); *(u32x4*)(OA + off + 8) = pack8(v[2], v[3]);
        }
    }


    SEAM(3);

    if (IN(4)) {
        pg8::Gemm g{OA, OB, Wbd, Wbf, 1024};
        pg8::P3Order S{G, bx};
        pg8::EpiP3 E{Gt, MGT, MG};
        pg8::gemm_phase(lds, g, S, E);
    }
    SEAM(4);

    if (IN(5)) {
        pg8::Gemm g{MG, MG, Wout, Wout, DM};
        pg8::PlainOrder S{32, 8, G, bx};
        pg8::EpiP4 E{x, (bf16_t*)(ws + WS_X1B), SS2};
        pg8::gemm_phase(lds, g, S, E);
    }
    SEAM(5);

    if (IN(6)) {
        pg8::Gemm g{(const bf16_t*)(ws + WS_X1B), (const bf16_t*)(ws + WS_X1B), Wup, Wup, DM};
        pg8::PlainOrder S{32, 32, G, bx};
        pg8::Unit u0; int pm0 = -1;
        if (S.next(0, u0)) { pm0 = u0.pm;
            LAS float* tab = (LAS float*)(lds + EPI_SCR_OFF);
            if (tid < 256) { const f32x4* sp = (const f32x4*)(SS2 + (size_t)(pm0 * 256 + tid) * 32); f32x4 sa = sp[0];
#pragma unroll
                for (int q = 1; q < 8; ++q) sa += sp[q];
                tab[tid] = fast_rsq(((sa[0] + sa[1]) + (sa[2] + sa[3])) * (1.f / DM) + EPS); }
            __syncthreads(); }
        pg8::EpiP5 E{SS2, U, pm0};
        pg8::gemm_phase(lds, g, S, E);
    }
    SEAM(6);

    if (IN(7)) {
        pg8::Gemm g{U, U, Wdown, Wdown, FF};
        pg8::PlainOrder S{32, 8, G, bx};
        pg8::EpiP6 E{(const bf16_t*)(ws + WS_X1B), out};
        pg8::gemm_phase(lds, g, S, E);
    }
#undef IN
#undef SEAM
}

#ifdef PROBE_PHASE
__global__ void dump_bf16(const bf16_t* a, const bf16_t* b, float* dst, size_t nhalf) {
    for (size_t i = blockIdx.x * (size_t)blockDim.x + threadIdx.x; i < nhalf; i += (size_t)gridDim.x * blockDim.x) { dst[i] = bf_lo((unsigned)a[i]); dst[nhalf + i] = bf_lo((unsigned)b[i]); }
}
#endif
extern "C" void kernel_launch(void* const* d_in, const int* in_sizes, int n_in, void* d_out, int out_size, void* d_ws, size_t ws_size, hipStream_t stream) {
    static int grid = 0;
    if (grid == 0) {
        if (n_in != 21 || out_size != SEQ * DM || ws_size < WS_END) { fprintf(stderr, "kernel_launch: unexpected problem (n_in %d, out %d, ws %zu)\n", n_in, out_size, ws_size); grid = -1; return; }
        int dev = 0, cus = 0, per_cu = 0;
        hipGetDevice(&dev);
        hipDeviceGetAttribute(&cus, hipDeviceAttributeMultiprocessorCount, dev);
        hipFuncSetAttribute((const void*)fwd_kernel, hipFuncAttributeMaxDynamicSharedMemorySize, LDS_BYTES);
        hipOccupancyMaxActiveBlocksPerMultiprocessor(&per_cu, (const void*)fwd_kernel, NTHREADS, LDS_BYTES);
        if (per_cu < 1) { fprintf(stderr, "kernel_launch: occupancy query says %d blocks per CU\n", per_cu); per_cu = 1; }
        if (per_cu > 1) per_cu = 1;
        grid = cus * per_cu;
        (void)hipGetLastError();
    }
    if (grid < 0) return;
    (void)hipMemsetAsync((char*)d_ws + WS_CTL, 0, CTL_BYTES, stream);
    Args a{};
    for (int i = 0; i < 21; ++i) a.in[i] = (const float*)d_in[i];
    a.out = (float*)d_out; a.ws = (unsigned char*)d_ws;
#if REPEAT_PHASE >= 0
    for (int p = 0; p < 8; ++p) { a.ph_lo = p; a.ph_hi = p + 1; a.att_sel = 0; hipLaunchKernelGGL(fwd_kernel, dim3(grid), dim3(NTHREADS), LDS_BYTES, stream, a);
        if ((REPEAT_PHASE >> p) & 1) { a.att_sel = REPEAT_PHASE >> 8; (void)hipMemsetAsync((char*)d_ws + WS_CTL, 0, 64, stream); hipLaunchKernelGGL(fwd_kernel, dim3(grid), dim3(NTHREADS), LDS_BYTES, stream, a); } }
#elif MK_N_LAUNCHES == 1
    a.ph_lo = 0; a.ph_hi = 8;
    void* kargs[] = {&a};
    hipError_t e = hipLaunchCooperativeKernel((const void*)fwd_kernel, dim3(grid), dim3(NTHREADS), kargs, LDS_BYTES, stream);
    if (e != hipSuccess) fprintf(stderr, "cooperative launch failed: %s (grid %d)\n", hipGetErrorString(e), grid);
#else
#ifdef PROBE_PHASE
    for (int p = 0; p <= PROBE_PHASE; ++p) { a.ph_lo = p; a.ph_hi = p + 1; hipLaunchKernelGGL(fwd_kernel, dim3(grid), dim3(NTHREADS), LDS_BYTES, stream, a); }
    { const unsigned char* w = (const unsigned char*)d_ws; hipLaunchKernelGGL(dump_bf16, dim3(2048), dim3(256), 0, stream, (const bf16_t*)(w + PROBE_A), (const bf16_t*)(w + PROBE_B), (float*)d_out, (size_t)SEQ * 1024); }
#else
    for (int p = 0; p < 8; ++p) { a.ph_lo = p; a.ph_hi = p + 1; hipLaunchKernelGGL(fwd_kernel, dim3(grid), dim3(NTHREADS), LDS_BYTES, stream, a); }
#endif
#endif
}
```
